# Optimizing an MI355X kernel written in HIP

```python
import math
import jax, jax.numpy as jnp
from jax import lax
import numpy as np

D_MODEL = 1024
BATCH = 1
SEQ = 16384
DEPTH = 1
DEC_BATCH = 32
DEC_SEQ = 16
PAST_LEN = 4096

CHUNK = 64
N_META = 16
HEAD_DIM = 64
DA_HEADS = 4
DA_WIDTH = DA_HEADS * 2 * HEAD_DIM
RW_HEADS = 8
RW_WIDTH = RW_HEADS * HEAD_DIM
W_LORA = 64
A_LORA = 64
G_LORA = 128
RW_PROJ = 3 * RW_WIDTH + W_LORA + A_LORA + G_LORA
RW_SPLITS = (RW_WIDTH, 2 * RW_WIDTH, 3 * RW_WIDTH, 3 * RW_WIDTH + W_LORA, 3 * RW_WIDTH + W_LORA + A_LORA)
IN_PROJ = 3 * DA_WIDTH + RW_PROJ
D_FF = 2816
CONV_W = 3
N_BUCKETS = 32
MAX_DISTANCE = 128
Q_BLOCK = 128
NORM_EPS = 1e-6
GN_EPS = 64e-5
NEG_INF = -1e30
F32 = jnp.float32

kernel_name = 'hymba_diffattn_rwkv7_convglu_stream_step'


def rms_norm(x, g, eps=NORM_EPS):
    xf = x.astype(F32)
    y = xf * lax.rsqrt(jnp.mean(xf * xf, axis=-1, keepdims=True) + eps)
    return (y * g.astype(F32)).astype(x.dtype)


def ext_pos_chunk(n):
    pos = jnp.arange(n, dtype=jnp.int32)
    chunk = jnp.where(pos < N_META, -1, (pos - N_META) // CHUNK)
    return pos, chunk


def rel_bucket(rel):
    nb = N_BUCKETS // 2
    max_exact = nb // 2
    bucket = jnp.where(rel > 0, nb, 0)
    n = jnp.abs(rel)
    nf = jnp.maximum(n, 1).astype(F32)
    large = max_exact + (jnp.log(nf / max_exact) / math.log(MAX_DISTANCE / max_exact) * (nb - max_exact)).astype(jnp.int32)
    large = jnp.minimum(large, nb - 1)
    return bucket + jnp.where(n < max_exact, n, large)


def diff_attention(q, k, v, q_pos, q_chunk, k_pos, k_chunk, rel_bias, lam):
    s = jnp.einsum('bqhcd,bkhcd->bchqk', q, k, preferred_element_type=F32) * (HEAD_DIM ** -0.5)
    bias = jnp.transpose(rel_bias[rel_bucket(k_pos[None, :] - q_pos[:, None])], (2, 0, 1)).astype(F32)
    mask = k_chunk[None, :] <= q_chunk[:, None]
    p = jax.nn.softmax(jnp.where(mask, s + bias, NEG_INF), axis=-1)
    a = p[:, 0] - lam * p[:, 1]
    return jnp.einsum('bhqk,bkhe->bqhe', a.astype(v.dtype), v)


def prompt_diff_attention(q, k, v, rel_bias, lam):
    B, L = q.shape[0], q.shape[1]
    n_blk = -(-L // Q_BLOCK)
    pad = n_blk * Q_BLOCK - L
    pos, chunk = ext_pos_chunk(n_blk * Q_BLOCK)
    qb = jnp.pad(q, ((0, 0), (0, pad), (0, 0), (0, 0), (0, 0)))
    qb = jnp.moveaxis(qb.reshape(B, n_blk, Q_BLOCK, DA_HEADS, 2, HEAD_DIM), 1, 0)
    k_pos, k_chunk = pos[:L], chunk[:L]

    def one_block(blk):
        q_blk, qp, qc = blk
        return diff_attention(q_blk, k, v, qp, qc, k_pos, k_chunk, rel_bias, lam)

    out = lax.map(one_block, (qb, pos.reshape(n_blk, Q_BLOCK), chunk.reshape(n_blk, Q_BLOCK)))
    out = jnp.moveaxis(out, 0, 1).reshape(B, n_blk * Q_BLOCK, DA_HEADS, 2 * HEAD_DIM)
    return out[:, :L]


def rwkv7_scan(r, w, k, v, a_in, b, s0):
    def step(S, xs):
        r_t, w_t, k_t, v_t, a_t, b_t = xs
        sa = jnp.einsum('bhij,bhj->bhi', S, a_t)
        S = S * w_t[:, :, None, :] + sa[..., None] * b_t[:, :, None, :] + v_t[..., None] * k_t[:, :, None, :]
        return S, jnp.einsum('bhij,bhj->bhi', S, r_t)

    xs = tuple(jnp.moveaxis(t.astype(F32), 1, 0) for t in (r, w, k, v, a_in, b))
    s_final, ys = lax.scan(step, s0.astype(F32), xs)
    return jnp.moveaxis(ys, 0, 1), s_final


def hybrid_layer(x, past_k, past_v, s0, shift0, conv0, rel_bias, lam_init,
                 ln1_g, w_in, q_norm_g, k_norm_g, lam_q1, lam_k1, lam_q2, lam_k2, subln_g,
                 mu_shift, w0, w2, a0, a2, g2, k_k, k_a, r_k, lnx_w, lnx_b, w_out,
                 ln2_g, w_up, conv_w, conv_b, w_down):
    B, T, _ = x.shape
    h = rms_norm(x, ln1_g)
    proj = h @ w_in
    q, k, v, pr = jnp.split(proj, [DA_WIDTH, 2 * DA_WIDTH, 3 * DA_WIDTH], axis=-1)

    q = rms_norm(q.reshape(B, T, DA_HEADS, 2, HEAD_DIM), q_norm_g)
    k = rms_norm(k.reshape(B, T, DA_HEADS, 2, HEAD_DIM), k_norm_g)
    v = v.reshape(B, T, DA_HEADS, 2 * HEAD_DIM)
    lam = (jnp.exp(jnp.sum(lam_q1.astype(F32) * lam_k1.astype(F32)))
           - jnp.exp(jnp.sum(lam_q2.astype(F32) * lam_k2.astype(F32))) + lam_init)
    if past_k is None:
        o = prompt_diff_attention(q, k, v, rel_bias, lam)
    else:
        k_all = jnp.concatenate([past_k.astype(k.dtype).reshape(B, -1, DA_HEADS, 2, HEAD_DIM), k], axis=1)
        v_all = jnp.concatenate([past_v.astype(v.dtype), v], axis=1)
        n_keys = k_all.shape[1]
        k_pos, k_chunk = ext_pos_chunk(n_keys)
        o = diff_attention(q, k_all, v_all, k_pos[n_keys - T:], k_chunk[n_keys - T:], k_pos, k_chunk, rel_bias, lam)
    o = rms_norm(o, subln_g) * (1.0 - lam_init)

    prev = jnp.concatenate([shift0[:, None, :].astype(pr.dtype), pr[:, :-1]], axis=1)
    xm = pr + (prev - pr) * mu_shift
    r, kr, vr, wd, ad, gd = jnp.split(xm, RW_SPLITS, axis=-1)
    w_log = -jax.nn.softplus(-(w0 + jnp.tanh(wd) @ w2).astype(F32)) - 0.5
    decay = jnp.exp(-jnp.exp(w_log))
    a = jax.nn.sigmoid(a0 + ad @ a2)
    g = jax.nn.sigmoid(gd) @ g2

    def heads(t):
        return t.reshape(B, T, RW_HEADS, HEAD_DIM)

    kk = heads(kr * k_k).astype(F32)
    kk = kk / jnp.maximum(jnp.sqrt(jnp.sum(kk * kk, axis=-1, keepdims=True)), 1e-12)
    kr = kr * (1.0 + (a - 1.0) * k_a)
    y, s_new = rwkv7_scan(heads(r), heads(decay), heads(kr), heads(vr), -kk, kk * heads(a).astype(F32), s0)
    mean = jnp.mean(y, axis=-1, keepdims=True)
    var = jnp.mean(jnp.square(y - mean), axis=-1, keepdims=True)
    y = ((y - mean) * lax.rsqrt(var + GN_EPS)).reshape(B, T, RW_WIDTH) * lnx_w + lnx_b
    bonus = jnp.sum(heads(r) * heads(kr) * r_k, axis=-1, keepdims=True) * heads(vr)
    o_rw = ((y + bonus.reshape(B, T, RW_WIDTH).astype(F32)) * g).astype(x.dtype)

    mixed = jnp.concatenate([o.reshape(B, T, DA_HEADS * 2 * HEAD_DIM).astype(x.dtype), o_rw], axis=-1) @ w_out
    x = x + mixed

    z = rms_norm(x, ln2_g) @ w_up
    zp = jnp.concatenate([conv0.astype(z.dtype), z], axis=1)
    zc = conv_b
    for j in range(CONV_W):
        zc = zc + zp[:, j:j + T] * conv_w[j]
    gate, up = jnp.split(zc, 2, axis=-1)
    x = x + (jax.nn.silu(gate) * up) @ w_down
    return x, k.reshape(B, T, DA_HEADS, 2 * HEAD_DIM), v, s_new, pr[:, -1], zp[:, T:]


def setup_inputs(seed: int = 0) -> dict:
    key = jax.random.key(seed)
    ks = jax.random.split(key, 40)

    def nrm(i, shape, scale=1.0):
        return jax.random.normal(ks[i], shape, F32) * scale

    def gain(i, shape):
        return 1.0 + nrm(i, shape, 0.02)

    L = DEPTH
    return {
        'x_prompt': nrm(0, (BATCH, SEQ, D_MODEL)),
        'x_sample': nrm(1, (DEC_BATCH, DEC_SEQ, D_MODEL)),
        'cache_k': nrm(2, (L, DEC_BATCH, N_META + PAST_LEN, DA_HEADS, 2 * HEAD_DIM)),
        'cache_v': nrm(3, (L, DEC_BATCH, N_META + PAST_LEN, DA_HEADS, 2 * HEAD_DIM)),
        'state_rwkv': nrm(4, (L, DEC_BATCH, RW_HEADS, HEAD_DIM, HEAD_DIM), 0.5),
        'state_shift': nrm(5, (L, DEC_BATCH, RW_PROJ)),
        'state_conv': nrm(6, (L, DEC_BATCH, CONV_W - 1, 2 * D_FF)),
        'meta_tokens': nrm(7, (N_META, D_MODEL)),
        'rel_bias': nrm(8, (N_BUCKETS, DA_HEADS), 0.5),
        'ln1_g': gain(9, (L, D_MODEL)),
        'w_in': nrm(10, (L, D_MODEL, IN_PROJ), D_MODEL ** -0.5),
        'q_norm_g': gain(11, (L, HEAD_DIM)),
        'k_norm_g': gain(12, (L, HEAD_DIM)),
        'lam_q1': nrm(13, (L, HEAD_DIM), 0.1),
        'lam_k1': nrm(14, (L, HEAD_DIM), 0.1),
        'lam_q2': nrm(15, (L, HEAD_DIM), 0.1),
        'lam_k2': nrm(16, (L, HEAD_DIM), 0.1),
        'subln_g': gain(17, (L, 2 * HEAD_DIM)),
        'mu_shift': jax.random.uniform(ks[18], (L, RW_PROJ), F32),
        'w0': jax.random.uniform(ks[19], (L, RW_WIDTH), F32, -4.0, 1.0),
        'w2': nrm(20, (L, W_LORA, RW_WIDTH), 0.1),
        'a0': nrm(21, (L, RW_WIDTH), 0.1),
        'a2': nrm(22, (L, A_LORA, RW_WIDTH), 0.1),
        'g2': nrm(23, (L, G_LORA, RW_WIDTH), G_LORA ** -0.5),
        'k_k': 0.85 + nrm(24, (L, RW_WIDTH), 0.02),
        'k_a': gain(25, (L, RW_WIDTH)),
        'r_k': nrm(26, (L, RW_HEADS, HEAD_DIM), 0.1),
        'lnx_w': gain(27, (L, RW_WIDTH)),
        'lnx_b': nrm(28, (L, RW_WIDTH), 0.02),
        'w_out': nrm(29, (L, D_MODEL, D_MODEL), D_MODEL ** -0.5),
        'ln2_g': gain(30, (L, D_MODEL)),
        'w_up': nrm(31, (L, D_MODEL, 2 * D_FF), D_MODEL ** -0.5),
        'conv_w': nrm(32, (L, CONV_W, 2 * D_FF), CONV_W ** -0.5),
        'conv_b': nrm(33, (L, 2 * D_FF), 0.02),
        'w_down': nrm(34, (L, D_FF, D_MODEL), D_FF ** -0.5),
    }


def reference(x_prompt, x_sample, cache_k, cache_v, state_rwkv, state_shift, state_conv,
              meta_tokens, rel_bias, ln1_g, w_in, q_norm_g, k_norm_g, lam_q1, lam_k1, lam_q2, lam_k2,
              subln_g, mu_shift, w0, w2, a0, a2, g2, k_k, k_a, r_k, lnx_w, lnx_b, w_out,
              ln2_g, w_up, conv_w, conv_b, w_down):
    Bp = x_prompt.shape[0]
    meta = jnp.broadcast_to(meta_tokens.astype(x_prompt.dtype)[None], (Bp, N_META, D_MODEL))
    xp = jnp.concatenate([meta, x_prompt], axis=1)
    xs = x_sample
    kp, vp, sp, hp, cp = [], [], [], [], []
    kq, vq, sq, hq, cq = [], [], [], [], []
    for l in range(DEPTH):
        lam_init = 0.8 - 0.6 * math.exp(-0.3 * l)
        lw = (ln1_g[l], w_in[l], q_norm_g[l], k_norm_g[l], lam_q1[l], lam_k1[l], lam_q2[l], lam_k2[l],
              subln_g[l], mu_shift[l], w0[l], w2[l], a0[l], a2[l], g2[l], k_k[l], k_a[l], r_k[l],
              lnx_w[l], lnx_b[l], w_out[l], ln2_g[l], w_up[l], conv_w[l], conv_b[l], w_down[l])
        xp, k_n, v_n, s_n, h_n, c_n = hybrid_layer(
            xp, None, None,
            jnp.zeros((Bp, RW_HEADS, HEAD_DIM, HEAD_DIM), F32),
            jnp.zeros((Bp, RW_PROJ), xp.dtype),
            jnp.zeros((Bp, CONV_W - 1, 2 * D_FF), xp.dtype),
            rel_bias, lam_init, *lw)
        kp.append(k_n); vp.append(v_n); sp.append(s_n); hp.append(h_n); cp.append(c_n)
        xs, k_n, v_n, s_n, h_n, c_n = hybrid_layer(
            xs, cache_k[l], cache_v[l], state_rwkv[l], state_shift[l], state_conv[l],
            rel_bias, lam_init, *lw)
        kq.append(k_n); vq.append(v_n); sq.append(s_n); hq.append(h_n); cq.append(c_n)
    return (xp[:, N_META:], xs,
            jnp.stack(kp), jnp.stack(vp), jnp.stack(sp), jnp.stack(hp), jnp.stack(cp),
            jnp.stack(kq), jnp.stack(vq), jnp.stack(sq), jnp.stack(hq), jnp.stack(cq))
```

```cpp
#include <hip/hip_runtime.h>
#include <hip/hip_bf16.h>
#include <cstdio>
#include <cstdint>
#include <cmath>

#ifndef MK_N_LAUNCHES
#define MK_N_LAUNCHES 13
#endif

namespace cfg {
constexpr int DM = 1024, SEQ = 16384, NMETA = 16, FPAD = 48;
constexpr int MP = FPAD + NMETA + SEQ;
constexpr int MPP = 16640;
constexpr int DB = 32, DT = 16, MD = DB * DT;
constexpr int M = MPP + MD;
constexpr int NCK = 4112;
constexpr int DA = 512, NPR = 1792, NPROJ = 3328, DFF = 2816, NUP = 5632, PR0 = 1536;
constexpr int NCH = 257;
constexpr int NT64 = 265;
constexpr float NORM_EPS = 1e-6f, GN_EPS = 64e-5f, LAM_INIT = 0.2f;
constexpr float QSCALE = 0.125f * 1.4426950408889634f;
constexpr size_t O_YP = 0, O_YS = O_YP + (size_t)SEQ * DM, O_KP = O_YS + (size_t)MD * DM, O_VP = O_KP + (size_t)(NMETA + SEQ) * 512,
    O_SP = O_VP + (size_t)(NMETA + SEQ) * 512, O_HP = O_SP + 8 * 4096, O_CP = O_HP + NPR, O_KS = O_CP + 2 * NUP, O_VS = O_KS + (size_t)MD * 512,
    O_SS = O_VS + (size_t)MD * 512, O_HS = O_SS + (size_t)DB * 8 * 4096, O_CS = O_HS + (size_t)DB * NPR, O_END = O_CS + (size_t)DB * 2 * NUP;
static_assert(O_END == 36131584, "output size");
}
namespace pg8 {
#define PG8_LAS __attribute__((address_space(3)))
typedef unsigned short bf16_t;
typedef short bf16x8 __attribute__((ext_vector_type(8)));
typedef float f32x4 __attribute__((ext_vector_type(4)));
typedef unsigned u32x4 __attribute__((ext_vector_type(4)));
constexpr int BM = 256, BK = 64, HALF = 128, HTB = HALF * BK * 2  , STAGE_BYTES = 8 * HTB, NXCD = 8, WGM = 8;

__host__ __device__ __forceinline__ int lds_byte(int r, int c) { const int st = (r >> 4) * 2 + (c >> 5), rr = r & 15, cc = c & 31, ob = rr * 64 + cc * 2; return st * 1024 + (ob ^ (((ob >> 9) & 1) << 5)); }
__host__ __device__ __forceinline__ void stage_rc(int b, int& R, int& C) { const int st = b / 1024, sb = b % 1024, swz = sb ^ (((sb >> 9) & 1) << 5); R = (st >> 1) * 16 + swz / 64; C = (st & 1) * 32 + (swz % 64) / 2; }
__host__ __device__ __forceinline__ int perm32(int rho) { const int n = rho >> 4, i = rho & 15; return 8 * (i >> 2) + 4 * n + (i & 3); }

struct Unit { int pm, pn; };
struct Gemm { const bf16_t* A; const bf16_t* Bt; int M, N, K; };

struct StaticOrder {
    int nM, nN, nwg, G, c;
    __host__ __device__ void init(int M, int N, int G_, int c_) { nM = M / BM; nN = N / BM; nwg = nM * nN; G = G_; c = c_; }
    __host__ __device__ bool next(int i, Unit& u) const {
        const long L = (long)i * G + c; if (L >= nwg) return false;
        int wgid = (int)L; { const int q = nwg / NXCD, r = nwg % NXCD, xcd = wgid % NXCD, off = wgid / NXCD; wgid = (xcd < r ? xcd * (q + 1) : r * (q + 1) + (xcd - r) * q) + off; }
        const int nig = WGM * nN, gid = wgid / nig, fm = gid * WGM, gsz = (nM - fm) < WGM ? (nM - fm) : WGM;
        u.pm = fm + ((wgid % nig) % gsz); u.pn = (wgid % nig) / gsz; return true;
    }
    __device__ __forceinline__ void a_ready(const Unit&) const {}
    __device__ __forceinline__ void done(const Unit&) const {}
};

__device__ __forceinline__ unsigned cvt_pk_bf16(float lo, float hi) { unsigned r; asm volatile("v_cvt_pk_bf16_f32 %0, %1, %2" : "=v"(r) : "v"(lo), "v"(hi)); return r; }
typedef float f32x2 __attribute__((ext_vector_type(2)));

__device__ __forceinline__ const float* x_src_row(int r, const float* xp, const float* xs, const float* meta) {
    using namespace cfg;
    if (r < FPAD) return nullptr;
    if (r < FPAD + NMETA) return meta + (size_t)(r - FPAD) * DM;
    if (r < MP) return xp + (size_t)(r - FPAD - NMETA) * DM;
    if (r < MPP) return nullptr;
    return xs + (size_t)(r - MPP) * DM;
}
struct EpiF32 {
    static constexpr bool PERM = false, AFTER_DRAIN = false;
    float* O; int ldc;
    __device__ __forceinline__ void operator()(const f32x4 (&acc)[2][2][4][2], const Unit& u, int wr, int wc, int fr, int fq) const {
        const int row0 = u.pm * BM + wr * 64 + fr, col0 = u.pn * BM + wc * 32 + 4 * fq;
#pragma unroll
        for (int ai = 0; ai < 2; ++ai)
#pragma unroll
            for (int m = 0; m < 4; ++m) { float* rowp = O + (size_t)(row0 + ai * HALF + m * 16) * ldc + col0;
#pragma unroll
                for (int bj = 0; bj < 2; ++bj)
#pragma unroll
                    for (int n = 0; n < 2; ++n) *(f32x4*)(rowp + bj * HALF + n * 16) = acc[ai][bj][m][n]; }
    }
};
struct EpiX1 {
    static constexpr bool PERM = false, AFTER_DRAIN = false;
    const float* xp; const float* xs; const float* meta; float* X1;
    __device__ __forceinline__ void operator()(const f32x4 (&acc)[2][2][4][2], const Unit& u, int wr, int wc, int fr, int fq) const {
        const int row0 = u.pm * BM + wr * 64 + fr, col0 = u.pn * BM + wc * 32 + 4 * fq;
#pragma unroll
        for (int ai = 0; ai < 2; ++ai)
#pragma unroll
            for (int m = 0; m < 4; ++m) { const int r = row0 + ai * HALF + m * 16; const float* src = x_src_row(r, xp, xs, meta); float* rowp = X1 + (size_t)r * cfg::DM + col0;
#pragma unroll
                for (int bj = 0; bj < 2; ++bj)
#pragma unroll
                    for (int n = 0; n < 2; ++n) { f32x4 v = (f32x4){0.f, 0.f, 0.f, 0.f}; if (src) v = *(const f32x4*)(src + col0 + bj * HALF + n * 16) + acc[ai][bj][m][n];
                        *(f32x4*)(rowp + bj * HALF + n * 16) = v; } }
    }
};
struct EpiBf {
    static constexpr bool PERM = true, AFTER_DRAIN = false;
    bf16_t* O; int ldc;
    __device__ __forceinline__ void operator()(const f32x4 (&acc)[2][2][4][2], const Unit& u, int wr, int wc, int fr, int fq) const {
        const int row0 = u.pm * BM + wr * 64 + fr, col0 = u.pn * BM + wc * 32 + 8 * fq;
#pragma unroll
        for (int ai = 0; ai < 2; ++ai)
#pragma unroll
            for (int m = 0; m < 4; ++m) { bf16_t* rowp = O + (size_t)(row0 + ai * HALF + m * 16) * ldc + col0;
#pragma unroll
                for (int bj = 0; bj < 2; ++bj) { const f32x4 v0 = acc[ai][bj][m][0], v1 = acc[ai][bj][m][1];
                    u32x4 w; w.x = cvt_pk_bf16(v0[0], v0[1]); w.y = cvt_pk_bf16(v0[2], v0[3]); w.z = cvt_pk_bf16(v1[0], v1[1]); w.w = cvt_pk_bf16(v1[2], v1[3]);
                    *(u32x4*)(rowp + bj * HALF) = w; } }
    }
};
struct EpiY {
    static constexpr bool PERM = false, AFTER_DRAIN = false;
    const float* X1; float* out;
    __device__ __forceinline__ void operator()(const f32x4 (&acc)[2][2][4][2], const Unit& u, int wr, int wc, int fr, int fq) const {
        using namespace cfg;
        const int row0 = u.pm * BM + wr * 64 + fr, col0 = u.pn * BM + wc * 32 + 4 * fq;
#pragma unroll
        for (int ai = 0; ai < 2; ++ai)
#pragma unroll
            for (int m = 0; m < 4; ++m) { const int r = row0 + ai * HALF + m * 16;
                float* dst = nullptr;
                if (r >= FPAD + NMETA && r < MP) dst = out + O_YP + (size_t)(r - FPAD - NMETA) * DM; else if (r >= MPP) dst = out + O_YS + (size_t)(r - MPP) * DM;
                if (dst) { const float* xr = X1 + (size_t)r * DM + col0;
#pragma unroll
                    for (int bj = 0; bj < 2; ++bj)
#pragma unroll
                        for (int n = 0; n < 2; ++n) *(f32x4*)(dst + col0 + bj * HALF + n * 16) = *(const f32x4*)(xr + bj * HALF + n * 16) + acc[ai][bj][m][n]; } }
    }
};

template <class Epi, class Sched, bool ALIGN_EPI = false, bool SP2 = false>
__device__ __forceinline__ void gemm_phase(PG8_LAS unsigned char* lds, const Gemm g, const Sched& S, const Epi& E) {
    const int tid = threadIdx.x, wid = __builtin_amdgcn_readfirstlane(tid >> 6), lane = tid & 63, wr = wid >> 2, wc = wid & 3, fr = lane & 15, fq = lane >> 4;
    const int K = g.K, nt = K / BK;
    unsigned voffA[2], voffB[2];
#pragma unroll
    for (int i = 0; i < 2; ++i) { int R, C; stage_rc(tid * 16 + i * 8192, R, C); const int Rb = Epi::PERM ? ((R & ~31) + perm32(R & 31)) : R;
        voffA[i] = (unsigned)(R * K + C) * 2u; voffB[i] = (unsigned)(Rb * K + C) * 2u; }
    const size_t kstep = (size_t)(BK * 2);
    const size_t hstep = (size_t)HALF * K * 2;
    const size_t tstep = 2 * hstep;
    const unsigned ldsw = (unsigned)wid * 1024u;
    const int aoff = lds_byte(wr * 64 + fr, fq * 8), boff = lds_byte(wc * 32 + fr, fq * 8);
#define PG8_SA(b, h) (((b) * 2 + (h)) * HTB)
#define PG8_SB(b, h) ((4 + (b) * 2 + (h)) * HTB)
#define PG8_STAGE(bufoff, gbase, voff) do { _Pragma("unroll") for (int _i = 0; _i < 2; ++_i) \
        __builtin_amdgcn_global_load_lds((const unsigned*)((const char*)(gbase) + (voff)[_i]), (PG8_LAS unsigned*)(lds + (bufoff) + ldsw + _i * 8192), 16, 0, 0); } while (0)
#define PG8_LDA(dst, b, h) do { _Pragma("unroll") for (int m = 0; m < 4; ++m) _Pragma("unroll") for (int k = 0; k < 2; ++k) dst[m][k] = *(const PG8_LAS bf16x8*)(lds + PG8_SA(b, h) + aoff + m * 2048 + k * 1024); } while (0)
#define PG8_LDB(dst, b, h) do { _Pragma("unroll") for (int n = 0; n < 2; ++n) _Pragma("unroll") for (int k = 0; k < 2; ++k) dst[n][k] = *(const PG8_LAS bf16x8*)(lds + PG8_SB(b, h) + boff + n * 2048 + k * 1024); } while (0)
#define PG8_MMA(ai, bj, At, Bt) do { __builtin_amdgcn_s_setprio(1); _Pragma("unroll") for (int m = 0; m < 4; ++m) _Pragma("unroll") for (int n = 0; n < 2; ++n) _Pragma("unroll") for (int k = 0; k < 2; ++k) \
        acc[ai][bj][m][n] = __builtin_amdgcn_mfma_f32_16x16x32_bf16(Bt[n][k], At[m][k], acc[ai][bj][m][n], 0, 0, 0); __builtin_amdgcn_s_setprio(0); } while (0)
#define PG8_WAIT_V(n) asm volatile("s_waitcnt vmcnt(" #n ")" ::: "memory")
#define PG8_WAIT_L(n) asm volatile("s_waitcnt lgkmcnt(" #n ")" ::: "memory")
#define PG8_BAR __builtin_amdgcn_s_barrier()
#define PG8_SCHED __builtin_amdgcn_sched_barrier(0)
    Unit cur, nxt; int ui = 0;
    if (!S.next(0, cur)) return;
    f32x4 acc[2][2][4][2];
#pragma unroll
    for (int a = 0; a < 2; ++a)
#pragma unroll
        for (int b = 0; b < 2; ++b)
#pragma unroll
            for (int m = 0; m < 4; ++m)
#pragma unroll
                for (int n = 0; n < 2; ++n) acc[a][b][m][n] = (f32x4){0.f, 0.f, 0.f, 0.f};
    bf16x8 At[4][2], B0[2][2], B1[2][2];
    const char* cA = (const char*)g.A + (size_t)cur.pm * tstep; const char* cB = (const char*)g.Bt + (size_t)cur.pn * tstep;
    S.a_ready(cur);
    if constexpr (SP2) {
        PG8_STAGE(PG8_SB(0, 0), cB, voffB); PG8_STAGE(PG8_SB(0, 1), cB + hstep, voffB); PG8_STAGE(PG8_SA(0, 0), cA, voffA); PG8_STAGE(PG8_SA(0, 1), cA + hstep, voffA);
        if (wr == 1) PG8_BAR;
        PG8_WAIT_V(2); PG8_BAR;
        PG8_STAGE(PG8_SB(1, 0), cB + kstep, voffB); PG8_STAGE(PG8_SA(1, 0), cA + kstep, voffA); PG8_STAGE(PG8_SB(1, 1), cB + hstep + kstep, voffB);
        PG8_WAIT_V(6); PG8_BAR;
    } else {
        PG8_STAGE(PG8_SB(0, 0), cB, voffB); PG8_STAGE(PG8_SA(0, 0), cA, voffA); PG8_STAGE(PG8_SB(0, 1), cB + hstep, voffB); PG8_STAGE(PG8_SA(0, 1), cA + hstep, voffA);
        if (wr == 1) PG8_BAR;
        PG8_WAIT_V(4); PG8_BAR;
        PG8_STAGE(PG8_SB(1, 0), cB + kstep, voffB); PG8_STAGE(PG8_SA(1, 0), cA + kstep, voffA); PG8_STAGE(PG8_SB(1, 1), cB + hstep + kstep, voffB);
        PG8_WAIT_V(6); PG8_BAR;
    }
    for (;;) {
        const bool has_next = S.next(ui + 1, nxt);
        const char* nA = has_next ? (const char*)g.A + (size_t)nxt.pm * tstep : cA; const char* nB = has_next ? (const char*)g.Bt + (size_t)nxt.pn * tstep : cB;
        for (int t = 0; t < nt; t += 2) {
            const bool last = (t == nt - 2);
            const char* a1 = cA + (size_t)(t + 1) * kstep;
            const char* a2 = last ? nA : cA + (size_t)(t + 2) * kstep; const char* b2 = last ? nB : cB + (size_t)(t + 2) * kstep;
            const char* a3 = a2 + kstep; const char* b3 = b2 + kstep;
            if (last && has_next) S.a_ready(nxt);
            if constexpr (SP2) {
            PG8_LDB(B0, 0, 0); PG8_LDB(B1, 0, 1); PG8_SCHED; PG8_LDA(At, 0, 0); PG8_STAGE(PG8_SA(1, 1), a1 + hstep, voffA);
            PG8_WAIT_V(8); PG8_WAIT_L(0); PG8_BAR; PG8_MMA(0, 0, At, B0); PG8_MMA(0, 1, At, B1); PG8_BAR; PG8_SCHED;
            PG8_LDA(At, 0, 1); PG8_STAGE(PG8_SB(0, 0), b2, voffB); PG8_STAGE(PG8_SB(0, 1), b2 + hstep, voffB); PG8_STAGE(PG8_SA(0, 0), a2, voffA);
            PG8_WAIT_V(8); PG8_WAIT_L(0); PG8_BAR; PG8_MMA(1, 0, At, B0); PG8_MMA(1, 1, At, B1); PG8_BAR; PG8_SCHED;
            PG8_LDB(B0, 1, 0); PG8_LDB(B1, 1, 1); PG8_SCHED; PG8_LDA(At, 1, 0); PG8_STAGE(PG8_SA(0, 1), a2 + hstep, voffA);
            PG8_WAIT_V(8); PG8_WAIT_L(0); PG8_BAR; PG8_MMA(0, 0, At, B0); PG8_MMA(0, 1, At, B1); PG8_BAR; PG8_SCHED;
            PG8_LDA(At, 1, 1); PG8_STAGE(PG8_SB(1, 0), b3, voffB); PG8_STAGE(PG8_SB(1, 1), b3 + hstep, voffB); PG8_STAGE(PG8_SA(1, 0), a3, voffA);
            PG8_WAIT_V(8); PG8_WAIT_L(0); PG8_BAR; PG8_MMA(1, 0, At, B0); PG8_MMA(1, 1, At, B1); PG8_BAR; PG8_SCHED;
            } else {
            PG8_LDB(B0, 0, 0); PG8_SCHED; PG8_LDA(At, 0, 0); PG8_STAGE(PG8_SA(1, 1), a1 + hstep, voffA);
            PG8_WAIT_L(8); PG8_BAR; PG8_WAIT_L(0); PG8_MMA(0, 0, At, B0); PG8_BAR; PG8_SCHED;
            PG8_LDB(B1, 0, 1); PG8_STAGE(PG8_SB(0, 0), b2, voffB);
            PG8_BAR; PG8_WAIT_L(0); PG8_MMA(0, 1, At, B1); PG8_BAR;
            PG8_LDA(At, 0, 1); PG8_STAGE(PG8_SA(0, 0), a2, voffA);
            PG8_BAR; PG8_WAIT_L(0); PG8_MMA(1, 0, At, B0); PG8_BAR; PG8_SCHED;
            PG8_STAGE(PG8_SB(0, 1), b2 + hstep, voffB);
            PG8_WAIT_V(6); PG8_BAR; PG8_MMA(1, 1, At, B1); PG8_BAR;
            PG8_LDB(B0, 1, 0); PG8_SCHED; PG8_LDA(At, 1, 0); PG8_STAGE(PG8_SA(0, 1), a2 + hstep, voffA);
            PG8_WAIT_L(8); PG8_BAR; PG8_WAIT_L(0); PG8_MMA(0, 0, At, B0); PG8_BAR; PG8_SCHED;
            PG8_LDB(B1, 1, 1); PG8_STAGE(PG8_SB(1, 0), b3, voffB);
            PG8_BAR; PG8_WAIT_L(0); PG8_MMA(0, 1, At, B1); PG8_BAR;
            PG8_LDA(At, 1, 1); PG8_STAGE(PG8_SA(1, 0), a3, voffA);
            PG8_BAR; PG8_WAIT_L(0); PG8_MMA(1, 0, At, B0); PG8_BAR; PG8_SCHED;
            PG8_STAGE(PG8_SB(1, 1), b3 + hstep, voffB);
            PG8_WAIT_V(6); PG8_BAR; PG8_MMA(1, 1, At, B1); PG8_BAR;
            }
        }
        if constexpr (ALIGN_EPI) { if (wr == 0) PG8_BAR; }
        if constexpr (!Epi::AFTER_DRAIN) { E(acc, cur, wr, wc, fr, fq); S.done(cur); }
        if (!has_next) break;
#pragma unroll
        for (int a = 0; a < 2; ++a)
#pragma unroll
            for (int b = 0; b < 2; ++b)
#pragma unroll
                for (int m = 0; m < 4; ++m)
#pragma unroll
                    for (int n = 0; n < 2; ++n) acc[a][b][m][n] = (f32x4){0.f, 0.f, 0.f, 0.f};
        cur = nxt; cA = nA; cB = nB; ++ui;
        if constexpr (ALIGN_EPI) { if (wr == 1) PG8_BAR; }
    }
    PG8_WAIT_V(0);
    if constexpr (!ALIGN_EPI) { if (wr == 0) PG8_BAR; }
    PG8_BAR;
    if constexpr (Epi::AFTER_DRAIN) { E.fused(acc, cur, wr, wc, fr, fq, lds, wid, lane); S.done(cur); }
#undef PG8_SA
#undef PG8_SB
#undef PG8_STAGE
#undef PG8_LDA
#undef PG8_LDB
#undef PG8_MMA
#undef PG8_WAIT_V
#undef PG8_WAIT_L
#undef PG8_BAR
#undef PG8_SCHED
}
}
#define GAS __attribute__((address_space(1)))
#define LAS __attribute__((address_space(3)))
typedef unsigned short bf16;
typedef unsigned v4u __attribute__((ext_vector_type(4)));
typedef float f32x4 __attribute__((ext_vector_type(4)));
typedef short bf16x8 __attribute__((ext_vector_type(8)));
typedef GAS unsigned gu32;
typedef GAS unsigned long long gu64;
#define RLX_AGENT __ATOMIC_RELAXED, __HIP_MEMORY_SCOPE_AGENT
#define LDS_WAIT() asm volatile("s_waitcnt lgkmcnt(0)" ::: "memory")
#define VM_WAIT() asm volatile("s_waitcnt vmcnt(0)" ::: "memory")
__device__ __forceinline__ unsigned long long rt() { return __builtin_amdgcn_s_memrealtime(); }
__device__ __forceinline__ unsigned f2bf(float f) { unsigned u = __builtin_bit_cast(unsigned, f); return (u + 0x7fffu + ((u >> 16) & 1u)) >> 16; }
__device__ __forceinline__ unsigned pk2(float lo, float hi) { return f2bf(lo) | (f2bf(hi) << 16); }

#define XB_TMO      128
#define XB_XCNT(j)  (256  + 64 * (j))
#define XB_XSUB(j)  (1280 + 64 * (j))
#define XB_XGEN(j)  (2304 + 64 * (j))
#define XB_TOP      3328
#define XB_TOPGEN   3392
#define XCD_BAR_WORDS 3456
#define XB_SPIN_CAP (1u << 18)

__device__ __forceinline__ unsigned xb_ld(unsigned* p)              { return __hip_atomic_load(p, __ATOMIC_RELAXED, __HIP_MEMORY_SCOPE_AGENT); }
__device__ __forceinline__ unsigned xb_add(unsigned* p, unsigned v) { return __hip_atomic_fetch_add(p, v, __ATOMIC_RELAXED, __HIP_MEMORY_SCOPE_AGENT); }
__device__ __forceinline__ unsigned xb_xcc_id() { return (unsigned)__builtin_amdgcn_s_getreg((3 << 11) | 20) & 0xFu; }
#define XB_SPIN(cond, bar) do { unsigned _sp = 0; while (cond) { __builtin_amdgcn_s_sleep(1); \
    if ((++_sp & 255u) == 0u) { if (xb_ld(&(bar)[XB_TMO])) break; if (_sp > XB_SPIN_CAP) { atomicAdd(&(bar)[XB_TMO], 1u); break; } } } } while (0)

struct XcdBarrier {
    unsigned* bar; unsigned x;
    volatile LAS unsigned* st;
};

__device__ __forceinline__ XcdBarrier xcd_barrier_post(unsigned* bar, volatile LAS unsigned* st) {
    XcdBarrier b; b.bar = bar; b.x = xb_xcc_id(); b.st = st;
    if (threadIdx.x == 0) (void)xb_add(&bar[XB_XCNT(b.x)], 1u);
    return b;
}
__device__ __forceinline__ void xcd_barrier_complete(unsigned* bar, unsigned x, unsigned& nloc, unsigned& nx) {
    const unsigned G = gridDim.x * gridDim.y * gridDim.z;
    unsigned sum, cnt, mine, sp = 0u;
    for (;;) {
        sum = 0u; cnt = 0u; mine = 0u;
#pragma unroll
        for (unsigned j = 0; j < 16; ++j) { const unsigned c = xb_ld(&bar[XB_XCNT(j)]); sum += c; cnt += (c > 0u) ? 1u : 0u; mine = (j == x) ? c : mine; }
        if (sum == G) break;
        __builtin_amdgcn_s_sleep(1);
        if ((++sp & 255u) == 0u) { if (xb_ld(&bar[XB_TMO])) break; if (sp > XB_SPIN_CAP) { atomicAdd(&bar[XB_TMO], 1u); break; } }
    }
    nloc = mine > 0u ? mine : 1u; nx = cnt > 0u ? cnt : 1u;
}

__device__ __forceinline__ void xcd_barrier(const XcdBarrier& b) {
    asm volatile("s_waitcnt vmcnt(0)" ::: "memory");
    __syncthreads();
    if (threadIdx.x == 0) {
        unsigned* bar = b.bar;
        __builtin_amdgcn_s_waitcnt(0);
        unsigned nloc = b.st[0], nx = b.st[1];
        if (nloc == 0u) { xcd_barrier_complete(bar, b.x, nloc, nx); b.st[0] = nloc; b.st[1] = nx; }
        const unsigned old = xb_add(&bar[XB_XSUB(b.x)], 1u);
        const unsigned gen = old / nloc;
        if (old + 1u == (gen + 1u) * nloc) {
            __builtin_amdgcn_fence(__ATOMIC_RELEASE, "agent");
            asm volatile("s_waitcnt vmcnt(0)" ::: "memory");
            const unsigned og = xb_add(&bar[XB_TOP], 1u);
            const unsigned tg = og / nx;
            if (og + 1u == (tg + 1u) * nx) xb_add(&bar[XB_TOPGEN], 1u);
            else XB_SPIN(xb_ld(&bar[XB_TOPGEN]) == tg, bar);
            __builtin_amdgcn_fence(__ATOMIC_ACQUIRE, "agent");
            xb_add(&bar[XB_XGEN(b.x)], 1u);
            asm volatile("s_waitcnt vmcnt(0)" ::: "memory");
        } else {
            XB_SPIN(xb_ld(&bar[XB_XGEN(b.x)]) == gen, bar);
            __builtin_amdgcn_fence(__ATOMIC_ACQUIRE, "agent");
            asm volatile("s_waitcnt vmcnt(0)" ::: "memory");
        }
    }
    __syncthreads();
}
constexpr size_t MiB = 1u << 20;
constexpr size_t WS_CTL = 0, CTL_ZERO_BYTES = 1 * MiB;
constexpr size_t WS_WIN = 2 * MiB, WS_WOUT = 9 * MiB, WS_WUP = 11 * MiB, WS_WDN = 22 * MiB, WS_W2T = 28 * MiB, WS_A2T = WS_W2T + 65536, WS_G2T = WS_A2T + 65536;
constexpr size_t WS_XN = 32 * MiB, WS_QB = 66 * MiB, WS_KB = 83 * MiB, WS_VB = 100 * MiB, WS_MIX = 117 * MiB, WS_X1 = 151 * MiB;
constexpr size_t WS_PROJ = 218 * MiB, WS_Z = WS_PROJ;
constexpr size_t WS_RW = 436 * MiB, RW_STRIDE = (size_t)cfg::M * 512 * 4, WS_ACT = WS_RW;
constexpr size_t WS_SC = 671 * MiB, SC_STRIDE = (size_t)cfg::M * 8 * 4;
constexpr size_t WS_YI = 673 * MiB, WS_QC = 707 * MiB, WS_PC = 740 * MiB, WS_GC = 773 * MiB, WS_S0 = 806 * MiB, WS_DPART = 839 * MiB, WS_DML = 871 * MiB, WS_END = 872 * MiB;
static_assert(WS_WIN + (size_t)3328 * 1024 * 2 <= WS_WOUT && WS_WUP + (size_t)5632 * 1024 * 2 <= WS_WDN && WS_WDN + (size_t)1024 * 2816 * 2 <= WS_W2T, "ws weights");
static_assert(WS_XN + (size_t)cfg::M * 1024 * 2 <= WS_QB && WS_QB + (size_t)cfg::M * 512 * 2 <= WS_KB && WS_VB + (size_t)cfg::M * 512 * 2 <= WS_MIX && WS_MIX + (size_t)cfg::M * 1024 * 2 <= WS_X1, "ws act");
static_assert(WS_X1 + (size_t)cfg::M * 1024 * 4 <= WS_PROJ && WS_PROJ + (size_t)cfg::M * 3328 * 4 <= WS_RW && WS_Z + (size_t)cfg::M * 5632 * 2 <= WS_RW, "ws proj");
static_assert(WS_RW + 7 * RW_STRIDE <= WS_SC && WS_SC + 3 * SC_STRIDE <= WS_YI && WS_YI + RW_STRIDE <= WS_QC && WS_QC + (size_t)8 * 257 * 4096 * 4 <= WS_PC, "ws rw");
static_assert(WS_PC + (size_t)8 * 257 * 4096 * 4 <= WS_GC && WS_GC + (size_t)8 * 257 * 4096 * 4 <= WS_S0 && WS_S0 + (size_t)8 * 257 * 4096 * 4 <= WS_DPART && WS_DPART + (size_t)256 * 8 * 2 * 2048 * 4 <= WS_DML, "ws rw2");
constexpr int CW_BAR = 4096;
constexpr int CW_QATT = 64, CW_QDEC = 128;

constexpr int RING_OFF = 0, RING_BYTES = 131072;
constexpr int LDSCTL_OFF = RING_BYTES, MISC_OFF = LDSCTL_OFF + 320;
constexpr int LDS_BYTES = 147456;
constexpr int NWAVES = 8;
constexpr int N_LAUNCHES = MK_N_LAUNCHES;
constexpr int N_PHASES = 13;

typedef float f32x16 __attribute__((ext_vector_type(16)));
typedef short s16x4 __attribute__((ext_vector_type(4)));
typedef short v4i16_t __attribute__((ext_vector_type(4)));

struct Args { const float* in[35]; float* out; unsigned char* ws; int ph_lo, ph_hi, li, pad; };
enum { I_XP = 0, I_XS, I_CK, I_CV, I_SRW, I_SSH, I_SCV, I_META, I_RELB, I_LN1, I_WIN, I_QNG, I_KNG, I_LQ1, I_LK1, I_LQ2, I_LK2, I_SUBLN, I_MU, I_W0, I_W2, I_A0, I_A2, I_G2,
       I_KK, I_KA, I_RK, I_LNXW, I_LNXB, I_WOUT, I_LN2, I_WUP, I_CONVW, I_CONVB, I_WDN };

__device__ __forceinline__ float wave_sum(float v) {
#pragma unroll
    for (int o = 1; o < 64; o <<= 1) v += __shfl_xor(v, o);
    return v;
}
__device__ __forceinline__ float quad_sum(float x) {
    x += __int_as_float(__builtin_amdgcn_mov_dpp(__float_as_int(x), 0xB1, 0xF, 0xF, true));
    x += __int_as_float(__builtin_amdgcn_mov_dpp(__float_as_int(x), 0x4E, 0xF, 0xF, true));
    return x;
}
__device__ __forceinline__ float sum16(float x) {
    x += __shfl_xor(x, 1); x += __shfl_xor(x, 2); x += __shfl_xor(x, 4); x += __shfl_xor(x, 8); return x;
}
__device__ __forceinline__ bf16x8 pack8(float a0, float a1, float a2, float a3, float a4, float a5, float a6, float a7) {
    v4u w; w.x = pk2(a0, a1); w.y = pk2(a2, a3); w.z = pk2(a4, a5); w.w = pk2(a6, a7); return __builtin_bit_cast(bf16x8, w);
}
__device__ __forceinline__ float sigm(float x) { return 1.0f / (1.0f + expf(-x)); }
__device__ __forceinline__ float ex2(float x) { return __builtin_amdgcn_exp2f(x); }
#define MFMA16(a, b, c) __builtin_amdgcn_mfma_f32_16x16x32_bf16((a), (b), (c), 0, 0, 0)
#define MFMA32(a, b, c) __builtin_amdgcn_mfma_f32_32x32x16_bf16((a), (b), (c), 0, 0, 0)
#define MFMA4F(a, b, c) __builtin_amdgcn_mfma_f32_16x16x4f32((a), (b), (c), 0, 0, 0)

__device__ __forceinline__ void p0_transpose_item(const float* W, int K, int N, bf16* WT, int row_off, LAS float* scr, int item, int lane) {
    const int nblk = N / 32, kb = item / nblk, nb = item % nblk, k0 = 64 * kb, n0 = 32 * nb;
#pragma unroll 8
    for (int i = 0; i < 32; ++i) { const int kk = 2 * i + (lane >> 5); scr[kk * 33 + (lane & 31)] = W[(size_t)(k0 + kk) * N + n0 + (lane & 31)]; }
    LDS_WAIT(); asm volatile("" ::: "memory");
    const int c = lane & 7;
#pragma unroll
    for (int j = 0; j < 4; ++j) { const int n = (lane >> 3) + 8 * j; const LAS float* s = scr + (8 * c) * 33 + n;
        v4u o; o.x = pk2(s[0 * 33], s[1 * 33]); o.y = pk2(s[2 * 33], s[3 * 33]); o.z = pk2(s[4 * 33], s[5 * 33]); o.w = pk2(s[6 * 33], s[7 * 33]);
        *(GAS v4u*)(WT + (size_t)(row_off + n0 + n) * K + k0 + 8 * c) = o; }
    LDS_WAIT(); asm volatile("" ::: "memory");
}
__device__ __forceinline__ void rms_row_bf16(const float* src, const float* gain, bf16* dst, int lane) {
    GAS unsigned long long* o8 = (GAS unsigned long long*)dst + lane;
    if (!src) {
#pragma unroll
        for (int j = 0; j < 4; ++j) o8[64 * j] = 0ull;
        return;
    }
    const GAS f32x4* xr = (const GAS f32x4*)src + lane; const GAS f32x4* gr = (const GAS f32x4*)gain + lane;
    f32x4 v[4]; float s = 0.f;
#pragma unroll
    for (int j = 0; j < 4; ++j) { v[j] = xr[64 * j]; s += (v[j].x * v[j].x + v[j].y * v[j].y) + (v[j].z * v[j].z + v[j].w * v[j].w); }
    const float rs = 1.0f / sqrtf(wave_sum(s) * (1.0f / 1024.0f) + cfg::NORM_EPS);
#pragma unroll
    for (int j = 0; j < 4; ++j) { const f32x4 g = gr[64 * j];
        o8[64 * j] = (unsigned long long)pk2(v[j].x * rs * g.x, v[j].y * rs * g.y) | ((unsigned long long)pk2(v[j].z * rs * g.z, v[j].w * rs * g.w) << 32); }
}
__device__ __forceinline__ void ph_prologue(const Args& a, LAS unsigned char* lds, int gw, int NGW, int wave, int lane) {
    using namespace cfg;
    LAS float* scr = (LAS float*)(lds + wave * 16384);
    unsigned char* ws = a.ws;
    constexpr int N_IN = 16 * 104, N_OUT = 16 * 32, N_UP = 16 * 176, N_DN = 44 * 32, N_W2 = 16, N_A2 = 16, N_G2 = 32;
    constexpr int NIT = N_IN + N_OUT + N_UP + N_DN + N_W2 + N_A2 + N_G2;
    for (int it = gw; it < NIT; it += NGW) {
        int r = it;
        if (r < N_IN) { p0_transpose_item(a.in[I_WIN], 1024, 3328, (bf16*)(ws + WS_WIN), 0, scr, r, lane); continue; } r -= N_IN;
        if (r < N_OUT) { p0_transpose_item(a.in[I_WOUT], 1024, 1024, (bf16*)(ws + WS_WOUT), 0, scr, r, lane); continue; } r -= N_OUT;
        if (r < N_UP) { p0_transpose_item(a.in[I_WUP], 1024, 5632, (bf16*)(ws + WS_WUP), 0, scr, r, lane); continue; } r -= N_UP;
        if (r < N_DN) { p0_transpose_item(a.in[I_WDN], 2816, 1024, (bf16*)(ws + WS_WDN), 0, scr, r, lane); continue; } r -= N_DN;
        if (r < N_W2) { p0_transpose_item(a.in[I_W2], 64, 512, (bf16*)(ws + WS_W2T), 0, scr, r, lane); continue; } r -= N_W2;
        if (r < N_A2) { p0_transpose_item(a.in[I_A2], 64, 512, (bf16*)(ws + WS_A2T), 0, scr, r, lane); continue; } r -= N_A2;
        p0_transpose_item(a.in[I_G2], 128, 512, (bf16*)(ws + WS_G2T), 0, scr, r, lane);
    }
    bf16* XN = (bf16*)(ws + WS_XN);
    for (int m = gw; m < M; m += NGW) rms_row_bf16(pg8::x_src_row(m, a.in[I_XP], a.in[I_XS], a.in[I_META]), a.in[I_LN1], XN + (size_t)m * DM, lane);
}

__device__ __forceinline__ void ph_rowpass(const Args& a, int gw, int NGW, int lane) {
    using namespace cfg;
    const float* PROJ = (const float*)(a.ws + WS_PROJ);
    bf16* Qb = (bf16*)(a.ws + WS_QB); bf16* Kb = (bf16*)(a.ws + WS_KB); bf16* Vb = (bf16*)(a.ws + WS_VB);
    float qg[8], kg[8];
#pragma unroll
    for (int i = 0; i < 8; ++i) { qg[i] = a.in[I_QNG][8 * (lane & 7) + i] * QSCALE; kg[i] = a.in[I_KNG][8 * (lane & 7) + i]; }
    for (int m = gw; m < M; m += NGW) {
        const float* p = PROJ + (size_t)m * NPROJ + 8 * lane;
        const f32x4 q0 = *(const f32x4*)p, q1 = *(const f32x4*)(p + 4), k0 = *(const f32x4*)(p + 512), k1 = *(const f32x4*)(p + 516), v0 = *(const f32x4*)(p + 1024), v1 = *(const f32x4*)(p + 1028);
        float sq = (q0.x * q0.x + q0.y * q0.y) + (q0.z * q0.z + q0.w * q0.w) + (q1.x * q1.x + q1.y * q1.y) + (q1.z * q1.z + q1.w * q1.w);
        float sk = (k0.x * k0.x + k0.y * k0.y) + (k0.z * k0.z + k0.w * k0.w) + (k1.x * k1.x + k1.y * k1.y) + (k1.z * k1.z + k1.w * k1.w);
        sq += __shfl_xor(sq, 1); sq += __shfl_xor(sq, 2); sq += __shfl_xor(sq, 4);
        sk += __shfl_xor(sk, 1); sk += __shfl_xor(sk, 2); sk += __shfl_xor(sk, 4);
        const float rq = 1.0f / sqrtf(sq * (1.0f / 64.0f) + NORM_EPS), rk = 1.0f / sqrtf(sk * (1.0f / 64.0f) + NORM_EPS);
        v4u w;
        w.x = pk2(q0.x * rq * qg[0], q0.y * rq * qg[1]); w.y = pk2(q0.z * rq * qg[2], q0.w * rq * qg[3]); w.z = pk2(q1.x * rq * qg[4], q1.y * rq * qg[5]); w.w = pk2(q1.z * rq * qg[6], q1.w * rq * qg[7]);
        *(v4u*)(Qb + (size_t)m * 512 + 8 * lane) = w;
        const f32x4 kn0 = {k0.x * rk * kg[0], k0.y * rk * kg[1], k0.z * rk * kg[2], k0.w * rk * kg[3]}, kn1 = {k1.x * rk * kg[4], k1.y * rk * kg[5], k1.z * rk * kg[6], k1.w * rk * kg[7]};
        w.x = pk2(kn0.x, kn0.y); w.y = pk2(kn0.z, kn0.w); w.z = pk2(kn1.x, kn1.y); w.w = pk2(kn1.z, kn1.w);
        *(v4u*)(Kb + (size_t)m * 512 + 8 * lane) = w;
        w.x = pk2(v0.x, v0.y); w.y = pk2(v0.z, v0.w); w.z = pk2(v1.x, v1.y); w.w = pk2(v1.z, v1.w);
        *(v4u*)(Vb + (size_t)m * 512 + 8 * lane) = w;
        float* kdst = nullptr; float* vdst = nullptr; float* sdst = nullptr;
        if (m >= FPAD && m < MP) { kdst = a.out + O_KP + (size_t)(m - FPAD) * 512; vdst = a.out + O_VP + (size_t)(m - FPAD) * 512; }
        else if (m >= MPP) { kdst = a.out + O_KS + (size_t)(m - MPP) * 512; vdst = a.out + O_VS + (size_t)(m - MPP) * 512; }
        if (kdst) { *(f32x4*)(kdst + 8 * lane) = kn0; *(f32x4*)(kdst + 8 * lane + 4) = kn1; *(f32x4*)(vdst + 8 * lane) = v0; *(f32x4*)(vdst + 8 * lane + 4) = v1; }
        if (m == MP - 1) sdst = a.out + O_HP; else if (m >= MPP && ((m - MPP) & 15) == 15) sdst = a.out + O_HS + (size_t)((m - MPP) >> 4) * NPR;
        if (sdst) { const float* pr = PROJ + (size_t)m * NPROJ + PR0; for (int c = lane; c < NPR; c += 64) sdst[c] = pr[c]; }
    }
}

__device__ __forceinline__ const float* prev_pr(int row, const float* PROJ, const float* sshift) {
    using namespace cfg;
    if (row < MPP) return row == 0 ? nullptr : PROJ + (size_t)(row - 1) * NPROJ + PR0;
    const int d = row - MPP;
    return (d & 15) == 0 ? sshift + (size_t)(d >> 4) * NPR : PROJ + (size_t)(row - 1) * NPROJ + PR0;
}
__device__ __forceinline__ void ph_rwkv_prep(const Args& a, LAS unsigned char* lds, int vcu, int G, int tid, int wave, int lane) {
    using namespace cfg;
    const float* PROJ = (const float*)(a.ws + WS_PROJ);
    float* AK = (float*)(a.ws + WS_RW); float* WD = (float*)(a.ws + WS_RW + RW_STRIDE); float* RR = (float*)(a.ws + WS_RW + 2 * RW_STRIDE); float* BB = (float*)(a.ws + WS_RW + 3 * RW_STRIDE);
    float* KP = (float*)(a.ws + WS_RW + 4 * RW_STRIDE); float* VV = (float*)(a.ws + WS_RW + 5 * RW_STRIDE); float* GG = (float*)(a.ws + WS_RW + 6 * RW_STRIDE);
    float* BR = (float*)(a.ws + WS_SC); float* KR = (float*)(a.ws + WS_SC + SC_STRIDE); float* RKR = (float*)(a.ws + WS_SC + 2 * SC_STRIDE);
    const bf16* W2T = (const bf16*)(a.ws + WS_W2T); const bf16* A2T = (const bf16*)(a.ws + WS_A2T); const bf16* G2T = (const bf16*)(a.ws + WS_G2T);
    const float* mu = a.in[I_MU];
    LAS bf16* TW = (LAS bf16*)(lds); LAS bf16* AD = (LAS bf16*)(lds + 9216); LAS bf16* SG = (LAS bf16*)(lds + 18432);
    const int h = wave, n = lane & 15, g = lane >> 4;
    float mur[4], muk[4], muv[4], w0v[4], a0v[4], kkv[4], kav[4], rkv[4];
#pragma unroll
    for (int nt = 0; nt < 4; ++nt) { const int cc = h * 64 + 16 * nt + n; mur[nt] = mu[cc]; muk[nt] = mu[512 + cc]; muv[nt] = mu[1024 + cc]; w0v[nt] = a.in[I_W0][cc]; a0v[nt] = a.in[I_A0][cc];
        kkv[nt] = a.in[I_KK][cc]; kav[nt] = a.in[I_KA][cc]; rkv[nt] = a.in[I_RK][cc]; }
    for (int tl = vcu; tl < NT64; tl += G) {
        const int row0 = tl < NCH ? 64 * tl : MPP + 64 * (tl - NCH);
        {
            const int t = tid >> 3, cg = (tid & 7) * 32, row = row0 + t, sect = cg >> 6;
            const float* p = PROJ + (size_t)row * NPROJ + 3072 + cg;
            const float* pv = prev_pr(row, PROJ, a.in[I_SSH]);
            const float* mq = mu + 1536 + cg;
            unsigned pk[16];
#pragma unroll
            for (int i = 0; i < 8; ++i) {
                const f32x4 x = *(const f32x4*)(p + 4 * i); f32x4 pr = (f32x4){0.f, 0.f, 0.f, 0.f}; if (pv) pr = *(const f32x4*)(pv + 1536 + cg + 4 * i);
                const f32x4 m4 = *(const f32x4*)(mq + 4 * i); f32x4 xm = x + (pr - x) * m4;
                if (sect == 0) { xm.x = tanhf(xm.x); xm.y = tanhf(xm.y); xm.z = tanhf(xm.z); xm.w = tanhf(xm.w); }
                else if (sect >= 2) { xm.x = sigm(xm.x); xm.y = sigm(xm.y); xm.z = sigm(xm.z); xm.w = sigm(xm.w); }
                pk[2 * i] = pk2(xm.x, xm.y); pk[2 * i + 1] = pk2(xm.z, xm.w);
            }
            LAS bf16* dst = sect == 0 ? TW + t * 72 + cg : sect == 1 ? AD + t * 72 + (cg - 64) : SG + t * 136 + (cg - 128);
#pragma unroll
            for (int i = 0; i < 4; ++i) *(LAS v4u*)(dst + 8 * i) = (v4u){pk[4 * i], pk[4 * i + 1], pk[4 * i + 2], pk[4 * i + 3]};
        }
        __syncthreads();
#pragma unroll 1
        for (int mt = 0; mt < 4; ++mt) {
            f32x4 cw[4], ca[4], cgv[4];
#pragma unroll
            for (int nt = 0; nt < 4; ++nt) { cw[nt] = (f32x4){0.f, 0.f, 0.f, 0.f}; ca[nt] = cw[nt]; cgv[nt] = cw[nt]; }
            bf16x8 aw[2], aa[2], ag[4];
#pragma unroll
            for (int ks = 0; ks < 2; ++ks) { aw[ks] = *(const LAS bf16x8*)(TW + (16 * mt + n) * 72 + 32 * ks + 8 * g); aa[ks] = *(const LAS bf16x8*)(AD + (16 * mt + n) * 72 + 32 * ks + 8 * g); }
#pragma unroll
            for (int ks = 0; ks < 4; ++ks) ag[ks] = *(const LAS bf16x8*)(SG + (16 * mt + n) * 136 + 32 * ks + 8 * g);
#pragma unroll
            for (int nt = 0; nt < 4; ++nt) {
                const int wr_ = h * 64 + 16 * nt + n;
#pragma unroll
                for (int ks = 0; ks < 2; ++ks) {
                    cw[nt] = MFMA16(aw[ks], *(const bf16x8*)(W2T + (size_t)wr_ * 64 + 32 * ks + 8 * g), cw[nt]);
                    ca[nt] = MFMA16(aa[ks], *(const bf16x8*)(A2T + (size_t)wr_ * 64 + 32 * ks + 8 * g), ca[nt]);
                }
#pragma unroll
                for (int ks = 0; ks < 4; ++ks) cgv[nt] = MFMA16(ag[ks], *(const bf16x8*)(G2T + (size_t)wr_ * 128 + 32 * ks + 8 * g), cgv[nt]);
                asm volatile("" ::: "memory");
            }
            float kraw[4][4], rr[4][4], vv[4][4], ssq[4] = {0.f, 0.f, 0.f, 0.f};
#pragma unroll
            for (int reg = 0; reg < 4; ++reg) {
                const int row = row0 + 16 * mt + 4 * g + reg;
                const float* p = PROJ + (size_t)row * NPROJ + PR0 + h * 64 + n;
                const float* pv = prev_pr(row, PROJ, a.in[I_SSH]);
#pragma unroll
                for (int nt = 0; nt < 4; ++nt) {
                    const float xr = p[16 * nt], xk = p[512 + 16 * nt], xv = p[1024 + 16 * nt];
                    float pr = 0.f, pk_ = 0.f, pvv = 0.f; if (pv) { pr = pv[h * 64 + n + 16 * nt]; pk_ = pv[512 + h * 64 + n + 16 * nt]; pvv = pv[1024 + h * 64 + n + 16 * nt]; }
                    rr[nt][reg] = xr + (pr - xr) * mur[nt]; kraw[nt][reg] = xk + (pk_ - xk) * muk[nt]; vv[nt][reg] = xv + (pvv - xv) * muv[nt];
                    const float kk_ = kraw[nt][reg] * kkv[nt]; ssq[reg] += kk_ * kk_;
                }
                asm volatile("" ::: "memory");
            }
            float inv[4], br[4], kr[4], rkr[4];
#pragma unroll
            for (int reg = 0; reg < 4; ++reg) { inv[reg] = 1.0f / fmaxf(sqrtf(sum16(ssq[reg])), 1e-12f); br[reg] = 0.f; kr[reg] = 0.f; rkr[reg] = 0.f; }
#pragma unroll
            for (int reg = 0; reg < 4; ++reg) {
                const int row = row0 + 16 * mt + 4 * g + reg;
#pragma unroll
                for (int nt = 0; nt < 4; ++nt) {
                    const float al = sigm(a0v[nt] + ca[nt][reg]);
                    const float xw = w0v[nt] + cw[nt][reg];
                    const float sp = fmaxf(-xw, 0.f) + log1pf(expf(-fabsf(xw)));
                    const float dec = expf(-expf(-sp - 0.5f));
                    const float kk = kraw[nt][reg] * kkv[nt] * inv[reg];
                    const float kp = kraw[nt][reg] * (1.0f + (al - 1.0f) * kav[nt]);
                    const float bb = kk * al, r_ = rr[nt][reg];
                    br[reg] += bb * r_; kr[reg] += kp * r_; rkr[reg] += r_ * kp * rkv[nt];
                    const unsigned idx = (unsigned)row * 512u + (unsigned)(h * 64 + 16 * nt + n);
                    AK[idx] = -kk; WD[idx] = dec; RR[idx] = r_; BB[idx] = bb; KP[idx] = kp; VV[idx] = vv[nt][reg]; GG[idx] = cgv[nt][reg];
                }
                asm volatile("" ::: "memory");
            }
#pragma unroll
            for (int reg = 0; reg < 4; ++reg) {
                const float b1 = sum16(br[reg]), k1 = sum16(kr[reg]), r1 = sum16(rkr[reg]);
                if (n == 0) { const size_t si = (size_t)(row0 + 16 * mt + 4 * g + reg) * 8 + h; BR[si] = b1; KR[si] = k1; RKR[si] = r1; }
            }
        }
        __syncthreads();
    }
}

__device__ __forceinline__ void ph_r1(const Args& a, int gw, int NGW, int lane) {
    using namespace cfg;
    const float* AK = (const float*)(a.ws + WS_RW); const float* WD = (const float*)(a.ws + WS_RW + RW_STRIDE); const float* RR = (const float*)(a.ws + WS_RW + 2 * RW_STRIDE);
    const float* BB = (const float*)(a.ws + WS_RW + 3 * RW_STRIDE); const float* KP = (const float*)(a.ws + WS_RW + 4 * RW_STRIDE); const float* VV = (const float*)(a.ws + WS_RW + 5 * RW_STRIDE);
    const float* BR = (const float*)(a.ws + WS_SC); const float* KR = (const float*)(a.ws + WS_SC + SC_STRIDE);
    float* YI = (float*)(a.ws + WS_YI); float* QC = (float*)(a.ws + WS_QC); float* PC = (float*)(a.ws + WS_PC); float* GC = (float*)(a.ws + WS_GC);
    constexpr int NUP_ = 8 * NCH * 2, NU = NUP_ + DB * 8;
    const int q = lane & 3, rg = lane >> 2;
    for (int u = gw; u < NU; u += NGW) {
        int h, row0, nstep, role, c = 0, b = 0; const bool dec = u >= NUP_;
        if (!dec) { role = u & 1; const int hc = u >> 1; h = hc & 7; c = hc >> 3; row0 = 64 * c; nstep = 64; }
        else { const int d = u - NUP_; b = d >> 3; h = d & 7; role = 0; row0 = MPP + 16 * b; nstep = 16; }
        float S[4][16];
#pragma unroll
        for (int ii = 0; ii < 4; ++ii) {
            const int i = rg + 16 * ii;
            if (dec) { const float* sp = a.in[I_SRW] + ((size_t)(b * 8 + h) * 64 + i) * 64 + 16 * q;
#pragma unroll
                for (int j4 = 0; j4 < 4; ++j4) { const f32x4 v = *(const f32x4*)(sp + 4 * j4); S[ii][4 * j4] = v.x; S[ii][4 * j4 + 1] = v.y; S[ii][4 * j4 + 2] = v.z; S[ii][4 * j4 + 3] = v.w; } }
            else {
#pragma unroll
                for (int jj = 0; jj < 16; ++jj) S[ii][jj] = (role == 1 && i == 16 * q + jj) ? 1.0f : 0.0f; }
        }
        float* yout = role == 0 ? YI + (size_t)row0 * 512 + h * 64 + rg + 16 * q : GC + (size_t)(h * NCH + c) * 4096 + rg + 16 * q;
        const int ystride = role == 0 ? 512 : 64;
#pragma unroll 1
        for (int t = 0; t < nstep; ++t) {
            const unsigned base = (unsigned)(row0 + t) * 512u + (unsigned)(h * 64 + 16 * q);
            f32x4 xa[4], xw[4], xr[4], xb[4], xk[4];
#pragma unroll
            for (int j4 = 0; j4 < 4; ++j4) { xa[j4] = *(const f32x4*)(AK + base + 4 * j4); xw[j4] = *(const f32x4*)(WD + base + 4 * j4); xr[j4] = *(const f32x4*)(RR + base + 4 * j4); }
#pragma unroll
            for (int j4 = 0; j4 < 4; ++j4) { xb[j4] = *(const f32x4*)(BB + base + 4 * j4); xk[j4] = *(const f32x4*)(KP + base + 4 * j4); }
            float vv[4] = {0.f, 0.f, 0.f, 0.f};
            if (role == 0) {
#pragma unroll
                for (int ii = 0; ii < 4; ++ii) vv[ii] = VV[(unsigned)(row0 + t) * 512u + (unsigned)(h * 64 + rg + 16 * ii)];
            }
            const float brs = BR[(unsigned)(row0 + t) * 8u + (unsigned)h], krs = KR[(unsigned)(row0 + t) * 8u + (unsigned)h];
#pragma unroll
            for (int j4 = 0; j4 < 4; ++j4) xr[j4] = xr[j4] * xw[j4];
            float ys[4];
#pragma unroll
            for (int ii = 0; ii < 4; ++ii) {
                float d1 = 0.f, d2 = 0.f;
#pragma unroll
                for (int jj = 0; jj < 16; ++jj) { d1 += S[ii][jj] * xa[jj >> 2][jj & 3]; d2 += S[ii][jj] * xr[jj >> 2][jj & 3]; }
                d1 = quad_sum(d1); d2 = quad_sum(d2);
                ys[ii] = d2 + d1 * brs + vv[ii] * krs;
#pragma unroll
                for (int jj = 0; jj < 16; ++jj) S[ii][jj] = S[ii][jj] * xw[jj >> 2][jj & 3] + d1 * xb[jj >> 2][jj & 3] + vv[ii] * xk[jj >> 2][jj & 3];
            }
            const float ysel = q == 0 ? ys[0] : q == 1 ? ys[1] : q == 2 ? ys[2] : ys[3];
            yout[(size_t)t * ystride] = ysel;
        }
        float* sout = dec ? a.out + O_SS + (size_t)(b * 8 + h) * 4096 : (role == 0 ? QC : PC) + (size_t)(h * NCH + c) * 4096;
#pragma unroll
        for (int ii = 0; ii < 4; ++ii) {
            float* sp = sout + (size_t)(rg + 16 * ii) * 64 + 16 * q;
#pragma unroll
            for (int j4 = 0; j4 < 4; ++j4) *(f32x4*)(sp + 4 * j4) = (f32x4){S[ii][4 * j4], S[ii][4 * j4 + 1], S[ii][4 * j4 + 2], S[ii][4 * j4 + 3]};
        }
    }
}

__device__ __forceinline__ void ph_r2(const Args& a, LAS unsigned char* lds, int unit, int wave, int lane) {
    using namespace cfg;
    const float* QC = (const float*)(a.ws + WS_QC); const float* PC = (const float*)(a.ws + WS_PC); float* S0T = (float*)(a.ws + WS_S0);
    const int h = unit >> 2, rb = unit & 3, n = lane & 15, g = lane >> 4, i = 16 * rb + n;
    LAS float* st = (LAS float*)lds;
    for (int x = threadIdx.x; x < 2048; x += 512) st[x] = 0.f;
    __syncthreads();
    f32x4 mine = (f32x4){0.f, 0.f, 0.f, 0.f};
    float pa[16]; f32x4 q4 = (f32x4){0.f, 0.f, 0.f, 0.f};
    if (wave < 4) {
        const float* pc = PC + (size_t)(h * NCH) * 4096 + 16 * wave + n;
#pragma unroll
        for (int kk = 0; kk < 16; ++kk) pa[kk] = pc[(16 * (kk >> 2) + 4 * g + (kk & 3)) * 64];
        q4 = *(const f32x4*)(QC + (size_t)(h * NCH) * 4096 + (size_t)i * 64 + 16 * wave + 4 * g);
    }
    for (int c = 0; c < NCH; ++c) {
        const int cur = c & 1;
        if (wave < 4) {
            float* s0 = S0T + (size_t)(h * NCH + c) * 4096 + (size_t)(16 * wave + 4 * g) * 64 + i;
#pragma unroll
            for (int reg = 0; reg < 4; ++reg) s0[reg * 64] = mine[reg];
            float pn[16]; f32x4 qn = (f32x4){0.f, 0.f, 0.f, 0.f};
            if (c + 1 < NCH) {
                const float* pc = PC + (size_t)(h * NCH + c + 1) * 4096 + 16 * wave + n;
#pragma unroll
                for (int kk = 0; kk < 16; ++kk) pn[kk] = pc[(16 * (kk >> 2) + 4 * g + (kk & 3)) * 64];
                qn = *(const f32x4*)(QC + (size_t)(h * NCH + c + 1) * 4096 + (size_t)i * 64 + 16 * wave + 4 * g);
            } else {
#pragma unroll
                for (int kk = 0; kk < 16; ++kk) pn[kk] = 0.f;
            }
            float bvv[16];
#pragma unroll
            for (int kk = 0; kk < 16; ++kk) bvv[kk] = st[cur * 1024 + (16 * (kk >> 2) + 4 * g + (kk & 3)) * 16 + n];
            f32x4 acc0 = q4, acc1 = (f32x4){0.f, 0.f, 0.f, 0.f};
#pragma unroll
            for (int kk = 0; kk < 16; kk += 2) { acc0 = MFMA4F(pa[kk], bvv[kk], acc0); acc1 = MFMA4F(pa[kk + 1], bvv[kk + 1], acc1); }
            mine = acc0 + acc1;
#pragma unroll
            for (int reg = 0; reg < 4; ++reg) st[(cur ^ 1) * 1024 + (16 * wave + 4 * g + reg) * 16 + n] = mine[reg];
#pragma unroll
            for (int kk = 0; kk < 16; ++kk) pa[kk] = pn[kk];
            q4 = qn;
        }
        __syncthreads();
    }
    if (wave < 4) *(f32x4*)(a.out + O_SP + (size_t)(h * 64 + i) * 64 + 16 * wave + 4 * g) = mine;
}

__device__ __forceinline__ void dec_attn_unit(const Args& a, const LAS float* tb, int unit, int wave, int lane) {
    using namespace cfg;
    const int b = unit >> 3, h = (unit >> 1) & 3, half = unit & 1, n = lane & 15, g = lane >> 4;
    const bf16* Qb = (const bf16*)(a.ws + WS_QB);
    bf16x8 qf[2][2];
#pragma unroll
    for (int c = 0; c < 2; ++c)
#pragma unroll
        for (int ks = 0; ks < 2; ++ks) qf[c][ks] = *(const bf16x8*)(Qb + (size_t)(MPP + b * 16 + n) * 512 + h * 128 + c * 64 + 32 * ks + 8 * g);
    float mr[2] = {-1e30f, -1e30f}, lr[2] = {0.f, 0.f};
    f32x4 o[2][8];
#pragma unroll
    for (int c = 0; c < 2; ++c)
#pragma unroll
        for (int et = 0; et < 8; ++et) o[c][et] = (f32x4){0.f, 0.f, 0.f, 0.f};
    const int send = half ? 129 : 64;
    for (int s = 64 * half + wave; s < send; s += 8) {
        f32x4 sa[2][2];
#pragma unroll
        for (int kt2 = 0; kt2 < 2; ++kt2) {
            const int kt16 = 2 * s + kt2;
            const float* kp = (kt16 < 257 ? a.in[I_CK] + ((size_t)b * NCK + 16 * kt16 + n) * 512 : a.out + O_KS + ((size_t)b * 16 + n) * 512) + h * 128 + 8 * g;
#pragma unroll
            for (int c = 0; c < 2; ++c) {
                f32x4 acc = (f32x4){0.f, 0.f, 0.f, 0.f};
#pragma unroll
                for (int ks = 0; ks < 2; ++ks) { const f32x4 x0 = *(const f32x4*)(kp + c * 64 + 32 * ks), x1 = *(const f32x4*)(kp + c * 64 + 32 * ks + 4);
                    acc = MFMA16(pack8(x0.x, x0.y, x0.z, x0.w, x1.x, x1.y, x1.z, x1.w), qf[c][ks], acc); }
                sa[c][kt2] = acc;
            }
        }
        if (s >= 120) {
#pragma unroll
            for (int kt2 = 0; kt2 < 2; ++kt2)
#pragma unroll
                for (int reg = 0; reg < 4; ++reg) { int idx = 16 * (2 * s + kt2) + 4 * g + reg - (NCK + n) + 191; idx = idx < 0 ? 0 : idx; const float bias = tb[idx];
                    sa[0][kt2][reg] += bias; sa[1][kt2][reg] += bias; }
        }
        bf16x8 pa[2];
#pragma unroll
        for (int c = 0; c < 2; ++c) {
            float mx = fmaxf(fmaxf(fmaxf(sa[c][0][0], sa[c][0][1]), fmaxf(sa[c][0][2], sa[c][0][3])), fmaxf(fmaxf(sa[c][1][0], sa[c][1][1]), fmaxf(sa[c][1][2], sa[c][1][3])));
            mx = fmaxf(mx, __shfl_xor(mx, 16)); mx = fmaxf(mx, __shfl_xor(mx, 32));
            const float mn = fmaxf(mr[c], mx), al = ex2(mr[c] - mn); mr[c] = mn;
            float p[8], ls = 0.f;
#pragma unroll
            for (int e = 0; e < 8; ++e) { p[e] = ex2(sa[c][e >> 2][e & 3] - mn); ls += p[e]; }
            lr[c] = lr[c] * al + ls;
            float alq[4];
#pragma unroll
            for (int reg = 0; reg < 4; ++reg) alq[reg] = __shfl(al, 4 * g + reg);
#pragma unroll
            for (int et = 0; et < 8; ++et) { o[c][et][0] *= alq[0]; o[c][et][1] *= alq[1]; o[c][et][2] *= alq[2]; o[c][et][3] *= alq[3]; }
            pa[c] = pack8(p[0], p[1], p[2], p[3], p[4], p[5], p[6], p[7]);
        }
        const float* vr[8];
#pragma unroll
        for (int jj = 0; jj < 8; ++jj) { const int kt16 = 2 * s + (jj >> 2), kr = 4 * g + (jj & 3);
            vr[jj] = (kt16 < 257 ? a.in[I_CV] + ((size_t)b * NCK + 16 * kt16 + kr) * 512 : a.out + O_VS + ((size_t)b * 16 + kr) * 512) + h * 128 + n; }
#pragma unroll
        for (int et = 0; et < 8; ++et) {
            const bf16x8 vf = pack8(vr[0][16 * et], vr[1][16 * et], vr[2][16 * et], vr[3][16 * et], vr[4][16 * et], vr[5][16 * et], vr[6][16 * et], vr[7][16 * et]);
            o[0][et] = MFMA16(pa[0], vf, o[0][et]); o[1][et] = MFMA16(pa[1], vf, o[1][et]);
        }
    }
    float* part = (float*)(a.ws + WS_DPART) + (size_t)(unit * 8 + wave) * 2 * 2048; float* ml = (float*)(a.ws + WS_DML) + (size_t)(unit * 8 + wave) * 2 * 32;
#pragma unroll
    for (int c = 0; c < 2; ++c) {
        float l = lr[c]; l += __shfl_xor(l, 16); l += __shfl_xor(l, 32);
        if (g == 0) { ml[c * 32 + 2 * n] = mr[c]; ml[c * 32 + 2 * n + 1] = l; }
#pragma unroll
        for (int et = 0; et < 8; ++et)
#pragma unroll
            for (int reg = 0; reg < 4; ++reg) part[c * 2048 + (4 * g + reg) * 128 + 16 * et + n] = o[c][et][reg];
    }
}
__device__ __forceinline__ void build_bias_table(LAS float* tb, const float* relb, int h, int tid) {
    if (tid < 256) {
        const int rel = tid - 191, nn = rel < 0 ? -rel : rel;
        int bk = nn < 8 ? nn : nn < 12 ? 8 : nn < 16 ? 9 : nn < 23 ? 10 : nn < 32 ? 11 : nn < 46 ? 12 : nn < 64 ? 13 : nn < 91 ? 14 : 15;
        if (rel > 0) bk += 16;
        tb[tid] = (relb[bk * 4 + h] - relb[15 * 4 + h]) * 1.4426950408889634f;
    }
}
__device__ __forceinline__ void ph_dec_attn(const Args& a, LAS unsigned char* lds, gu32* ctl, volatile LAS unsigned* misc, int tid, int wave, int lane) {
    LAS float* tb = (LAS float*)(lds + 65536);
    for (int hh = 0; hh < 4; ++hh) build_bias_table(tb + 256 * hh, a.in[I_RELB], hh, tid);
    __syncthreads();
    for (;;) {
        if (tid == 0) misc[4] = __hip_atomic_fetch_add(ctl + CW_QDEC, 1u, __ATOMIC_RELAXED, __HIP_MEMORY_SCOPE_AGENT);
        __syncthreads();
        const unsigned u = misc[4];
        __syncthreads();
        if (u >= 256u) break;
        dec_attn_unit(a, tb + 256 * ((u >> 1) & 3), (int)u, wave, lane);
    }
}

__device__ __forceinline__ void ph_r3(const Args& a, int gw, int NGW, int lane, float lam) {
    using namespace cfg;
    const float* GC = (const float*)(a.ws + WS_GC); const float* S0T = (const float*)(a.ws + WS_S0); const float* YI = (const float*)(a.ws + WS_YI);
    const float* VV = (const float*)(a.ws + WS_RW + 5 * RW_STRIDE); const float* GG = (const float*)(a.ws + WS_RW + 6 * RW_STRIDE); const float* RKR = (const float*)(a.ws + WS_SC + 2 * SC_STRIDE);
    bf16* MIX = (bf16*)(a.ws + WS_MIX);
    const int n = lane & 15, g = lane >> 4;
    for (int u = gw; u < NT64 * 8; u += NGW) {
        const int tl = u >> 3, h = u & 7, row0 = tl < NCH ? 64 * tl : MPP + 64 * (tl - NCH);
        f32x4 acc[4][4];
#pragma unroll
        for (int mt = 0; mt < 4; ++mt)
#pragma unroll
            for (int nt = 0; nt < 4; ++nt) acc[mt][nt] = (f32x4){0.f, 0.f, 0.f, 0.f};
        if (tl < NCH) {
            const float* gp = GC + (size_t)(h * NCH + tl) * 4096 + n * 64 + g;
            const float* sp = S0T + (size_t)(h * NCH + tl) * 4096 + g * 64 + n;
#pragma unroll 4
            for (int kk = 0; kk < 16; ++kk) {
                float av[4], bv[4];
#pragma unroll
                for (int x = 0; x < 4; ++x) { av[x] = gp[(size_t)x * 1024 + 4 * kk]; bv[x] = sp[(size_t)kk * 256 + 16 * x]; }
#pragma unroll
                for (int mt = 0; mt < 4; ++mt)
#pragma unroll
                    for (int nt = 0; nt < 4; ++nt) acc[mt][nt] = MFMA4F(av[mt], bv[nt], acc[mt][nt]);
            }
        }
        float lw[4], lb[4];
#pragma unroll
        for (int nt = 0; nt < 4; ++nt) { lw[nt] = a.in[I_LNXW][h * 64 + 16 * nt + n]; lb[nt] = a.in[I_LNXB][h * 64 + 16 * nt + n]; }
#pragma unroll
        for (int mt = 0; mt < 4; ++mt)
#pragma unroll
            for (int reg = 0; reg < 4; ++reg) {
                const int row = row0 + 16 * mt + 4 * g + reg; const size_t ib = (size_t)row * 512 + h * 64 + n;
                float y[4], s = 0.f;
#pragma unroll
                for (int nt = 0; nt < 4; ++nt) { y[nt] = acc[mt][nt][reg] + YI[ib + 16 * nt]; s += y[nt]; }
                const float mean = sum16(s) * (1.0f / 64.0f); float v2 = 0.f;
#pragma unroll
                for (int nt = 0; nt < 4; ++nt) { y[nt] -= mean; v2 += y[nt] * y[nt]; }
                const float rstd = 1.0f / sqrtf(sum16(v2) * (1.0f / 64.0f) + GN_EPS), rk = RKR[(size_t)row * 8 + h];
#pragma unroll
                for (int nt = 0; nt < 4; ++nt) { const float ov = (y[nt] * rstd * lw[nt] + lb[nt] + rk * VV[ib + 16 * nt]) * GG[ib + 16 * nt];
                    MIX[(size_t)row * 1024 + 512 + h * 64 + 16 * nt + n] = (bf16)f2bf(ov); }
            }
    }
    const float* part = (const float*)(a.ws + WS_DPART); const float* ml = (const float*)(a.ws + WS_DML);
    for (int rid = gw; rid < DB * 4 * 16; rid += NGW) {
        const int b = rid >> 6, h = (rid >> 4) & 3, q = rid & 15;
        float oc[2][2];
#pragma unroll
        for (int c = 0; c < 2; ++c) {
            float mm = -1e30f;
            for (int p = 0; p < 16; ++p) mm = fmaxf(mm, ml[(size_t)(((b * 4 + h) * 2 + (p >> 3)) * 8 + (p & 7)) * 64 + c * 32 + 2 * q]);
            float L = 0.f, o0 = 0.f, o1 = 0.f;
            for (int p = 0; p < 16; ++p) { const size_t pi = (size_t)(((b * 4 + h) * 2 + (p >> 3)) * 8 + (p & 7));
                const float wgt = ex2(ml[pi * 64 + c * 32 + 2 * q] - mm); L += ml[pi * 64 + c * 32 + 2 * q + 1] * wgt;
                o0 += part[pi * 4096 + c * 2048 + q * 128 + lane] * wgt; o1 += part[pi * 4096 + c * 2048 + q * 128 + 64 + lane] * wgt; }
            oc[c][0] = o0 / L; oc[c][1] = o1 / L;
        }
        const float d0 = oc[0][0] - lam * oc[1][0], d1 = oc[0][1] - lam * oc[1][1];
        const float rstd = 1.0f / sqrtf(wave_sum(d0 * d0 + d1 * d1) * (1.0f / 128.0f) + NORM_EPS);
        bf16* dst = MIX + (size_t)(MPP + b * 16 + q) * 1024 + h * 128;
        dst[lane] = (bf16)f2bf(d0 * rstd * a.in[I_SUBLN][lane] * (1.0f - LAM_INIT)); dst[64 + lane] = (bf16)f2bf(d1 * rstd * a.in[I_SUBLN][64 + lane] * (1.0f - LAM_INIT));
    }
}

__device__ __forceinline__ int crow(int r, int hi) { return (r & 3) + 8 * (r >> 2) + 4 * hi; }
__device__ __forceinline__ s16x4 vtr(const LAS unsigned char* p) { return __builtin_bit_cast(s16x4, __builtin_amdgcn_ds_read_tr16_b64_v4i16((LAS v4i16_t*)p)); }
__device__ __forceinline__ void attn_unit(const Args& a, LAS unsigned char* lds, int h, int qt, float lam, int tid, int wave, int lane) {
    using namespace cfg;
    const bf16* Qb = (const bf16*)(a.ws + WS_QB); const bf16* Kb = (const bf16*)(a.ws + WS_KB); const bf16* Vb = (const bf16*)(a.ws + WS_VB); bf16* MIX = (bf16*)(a.ws + WS_MIX);
    LAS float* tb = (LAS float*)(lds + 65536); LAS float* scr = (LAS float*)(lds + 65536 + 1024 + wave * 128);
    const int comp = wave >> 2, qg = wave & 3, r = lane & 31, hh = lane >> 5;
    const int ntile = 2 * qt + 2, my_nt = qg < 2 ? ntile - 1 : ntile, q0 = 128 * qt + 32 * qg;
    build_bias_table(tb, a.in[I_RELB], h, tid);
    bf16x8 qr[4];
#pragma unroll
    for (int d0 = 0; d0 < 4; ++d0) qr[d0] = *(const bf16x8*)(Qb + (size_t)(q0 + r) * 512 + h * 128 + comp * 64 + 16 * d0 + 8 * hh);
    f32x16 o[4];
#pragma unroll
    for (int eb = 0; eb < 4; ++eb)
#pragma unroll
        for (int x = 0; x < 16; ++x) o[eb][x] = 0.f;
    float m_run = -1e30f, l_run = 0.f;
    int srow[2], koff[2], voff[2]; size_t goff[2];
#pragma unroll
    for (int i = 0; i < 2; ++i) { const int cidx = tid + 512 * i, row = cidx >> 4, cc = cidx & 15; srow[i] = row; goff[i] = (size_t)row * 512 + h * 128 + cc * 8;
        koff[i] = (cc >> 3) * 8192 + row * 128 + (((cc & 7) ^ ((row >> 1) & 7)) << 4);
        voff[i] = 16384 + row * 256 + ((((cc >> 2) ^ (row & 3)) << 6) | ((cc & 3) << 4)); }
    v4u kreg[2], vreg[2];
#define ATT_LOAD(kt) do { _Pragma("unroll") for (int i = 0; i < 2; ++i) { kreg[i] = *(const v4u*)(Kb + (size_t)(kt) * 64 * 512 + goff[i]); vreg[i] = *(const v4u*)(Vb + (size_t)(kt) * 64 * 512 + goff[i]); } } while (0)
#define ATT_STORE(buf) do { _Pragma("unroll") for (int i = 0; i < 2; ++i) { *(LAS v4u*)(lds + (buf) * 32768 + koff[i]) = kreg[i]; *(LAS v4u*)(lds + (buf) * 32768 + voff[i]) = vreg[i]; } } while (0)
    ATT_LOAD(0); ATT_STORE(0);
    __syncthreads();
    const int li = lane & 15, cb = (lane >> 4) & 1;
    for (int kt = 0; kt < ntile; ++kt) {
        const bool more = kt + 1 < ntile;
        if (more) ATT_LOAD(kt + 1);
        if (kt < my_nt) {
            const LAS unsigned char* Kc = lds + (kt & 1) * 32768 + comp * 8192;
            const LAS unsigned char* Vc = lds + (kt & 1) * 32768 + 16384;
            f32x16 p0, p1;
#pragma unroll
            for (int x = 0; x < 16; ++x) { p0[x] = 0.f; p1[x] = 0.f; }
#pragma unroll
            for (int d0 = 0; d0 < 4; ++d0) {
                const int ch = 2 * d0 + hh, r1 = 32 + r;
                const bf16x8 kf0 = *(const LAS bf16x8*)(Kc + r * 128 + ((ch ^ ((r >> 1) & 7)) << 4));
                const bf16x8 kf1 = *(const LAS bf16x8*)(Kc + r1 * 128 + ((ch ^ ((r1 >> 1) & 7)) << 4));
                p0 = MFMA32(kf0, qr[d0], p0); p1 = MFMA32(kf1, qr[d0], p1);
            }
            if (kt + 4 >= ntile || kt == 0) {
                const int base = 64 * kt - (q0 + r) + 191;
#pragma unroll
                for (int x = 0; x < 16; ++x) { const int k0 = crow(x, hh); int i0 = base + k0, i1 = base + 32 + k0; i0 = i0 < 0 ? 0 : i0; i1 = i1 < 0 ? 0 : i1;
                    p0[x] += tb[i0]; p1[x] += tb[i1];
                    if (kt == 0) { if (k0 < FPAD) p0[x] = -1e30f; if (32 + k0 < FPAD) p1[x] = -1e30f; } }
            }
            float mx = fmaxf(p0[0], p1[0]);
#pragma unroll
            for (int x = 1; x < 16; ++x) mx = fmaxf(mx, fmaxf(p0[x], p1[x]));
            mx = fmaxf(mx, __shfl_xor(mx, 32));
            const float mnew = fmaxf(m_run, mx);
            if (__any(mnew > m_run)) {
                const float alpha = ex2(m_run - mnew); l_run *= alpha; m_run = mnew;
                if (hh == 0) scr[r] = alpha;
                LDS_WAIT(); asm volatile("" ::: "memory");
#pragma unroll
                for (int g4 = 0; g4 < 4; ++g4) { const f32x4 al = *(const LAS f32x4*)(scr + 8 * g4 + 4 * hh);
#pragma unroll
                    for (int eb = 0; eb < 4; ++eb) { o[eb][4 * g4] *= al.x; o[eb][4 * g4 + 1] *= al.y; o[eb][4 * g4 + 2] *= al.z; o[eb][4 * g4 + 3] *= al.w; } }
                LDS_WAIT(); asm volatile("" ::: "memory");
            }
            float ls = 0.f;
#pragma unroll
            for (int x = 0; x < 16; ++x) { p0[x] = ex2(p0[x] - m_run); p1[x] = ex2(p1[x] - m_run); ls += p0[x] + p1[x]; }
            l_run += ls;
            bf16x8 pa[4];
            pa[0] = pack8(p0[0], p0[1], p0[2], p0[3], p0[4], p0[5], p0[6], p0[7]); pa[1] = pack8(p0[8], p0[9], p0[10], p0[11], p0[12], p0[13], p0[14], p0[15]);
            pa[2] = pack8(p1[0], p1[1], p1[2], p1[3], p1[4], p1[5], p1[6], p1[7]); pa[3] = pack8(p1[8], p1[9], p1[10], p1[11], p1[12], p1[13], p1[14], p1[15]);
#pragma unroll
            for (int eb = 0; eb < 4; ++eb)
#pragma unroll
                for (int ks = 0; ks < 4; ++ks) {
                    const int qq = li >> 2, pp = li & 3, rowb = 16 * ks + 4 * hh + qq;
                    const LAS unsigned char* ad = Vc + rowb * 256 + ((eb ^ qq) << 6) + 32 * cb + 8 * pp;
                    const s16x4 lo = vtr(ad), hi = vtr(ad + 8 * 256);
                    const bf16x8 vf = (bf16x8){lo[0], lo[1], lo[2], lo[3], hi[0], hi[1], hi[2], hi[3]};
                    o[eb] = MFMA32(pa[ks], vf, o[eb]);
                }
        }
        if (more) ATT_STORE((kt + 1) & 1);
        __syncthreads();
    }
#undef ATT_LOAD
#undef ATT_STORE
    l_run += __shfl_xor(l_run, 32);
    { const float sc = (comp ? lam : 1.0f) / l_run;
      if (hh == 0) scr[r] = sc;
      LDS_WAIT(); asm volatile("" ::: "memory");
#pragma unroll
      for (int g4 = 0; g4 < 4; ++g4) { const f32x4 al = *(const LAS f32x4*)(scr + 8 * g4 + 4 * hh);
#pragma unroll
          for (int eb = 0; eb < 4; ++eb) { o[eb][4 * g4] *= al.x; o[eb][4 * g4 + 1] *= al.y; o[eb][4 * g4 + 2] *= al.z; o[eb][4 * g4 + 3] *= al.w; } }
    }
    LAS float* X = (LAS float*)lds + qg * 4096;
    if (comp == 1) {
#pragma unroll
        for (int eb = 0; eb < 4; ++eb)
#pragma unroll
            for (int x = 0; x < 16; ++x) X[crow(x, hh) * 128 + 32 * eb + r] = o[eb][x];
    }
    __syncthreads();
    if (comp == 0) {
#pragma unroll
        for (int eb = 0; eb < 4; ++eb)
#pragma unroll
            for (int x = 0; x < 16; ++x) { const int xi = crow(x, hh) * 128 + 32 * eb + r; X[xi] = o[eb][x] - X[xi]; }
    }
    __syncthreads();
    { const int row = tid >> 2, qtr = tid & 3; const LAS float* xr = (const LAS float*)lds + row * 128 + 32 * qtr;
      float d[32], ss = 0.f;
#pragma unroll
      for (int j4 = 0; j4 < 8; ++j4) { const f32x4 v = *(const LAS f32x4*)(xr + 4 * j4); d[4 * j4] = v.x; d[4 * j4 + 1] = v.y; d[4 * j4 + 2] = v.z; d[4 * j4 + 3] = v.w; ss += (v.x * v.x + v.y * v.y) + (v.z * v.z + v.w * v.w); }
      ss = quad_sum(ss);
      const float rstd = (1.0f - LAM_INIT) / sqrtf(ss * (1.0f / 128.0f) + NORM_EPS);
      const float* sg = a.in[I_SUBLN] + 32 * qtr;
      bf16* dst = MIX + (size_t)(128 * qt + row) * 1024 + h * 128 + 32 * qtr;
#pragma unroll
      for (int j8 = 0; j8 < 4; ++j8) { v4u w;
          w.x = pk2(d[8 * j8] * rstd * sg[8 * j8], d[8 * j8 + 1] * rstd * sg[8 * j8 + 1]); w.y = pk2(d[8 * j8 + 2] * rstd * sg[8 * j8 + 2], d[8 * j8 + 3] * rstd * sg[8 * j8 + 3]);
          w.z = pk2(d[8 * j8 + 4] * rstd * sg[8 * j8 + 4], d[8 * j8 + 5] * rstd * sg[8 * j8 + 5]); w.w = pk2(d[8 * j8 + 6] * rstd * sg[8 * j8 + 6], d[8 * j8 + 7] * rstd * sg[8 * j8 + 7]);
          *(v4u*)(dst + 8 * j8) = w; }
    }
    __syncthreads();
}
__device__ __forceinline__ void ph_attn(const Args& a, LAS unsigned char* lds, gu32* ctl, volatile LAS unsigned* misc, float lam, int tid, int wave, int lane) {
    for (;;) {
        if (tid == 0) misc[4] = __hip_atomic_fetch_add(ctl + CW_QATT, 1u, __ATOMIC_RELAXED, __HIP_MEMORY_SCOPE_AGENT);
        __syncthreads();
        const unsigned u = misc[4];
        __syncthreads();
        if (u >= 516u) break;
        attn_unit(a, lds, (int)(u & 3u), 128 - (int)(u >> 2), lam, tid, wave, lane);
    }
}

__device__ __forceinline__ void ph_norm2(const Args& a, int gw, int NGW, int lane) {
    const float* X1 = (const float*)(a.ws + WS_X1); bf16* XN = (bf16*)(a.ws + WS_XN);
    for (int m = gw; m < cfg::M; m += NGW) rms_row_bf16(X1 + (size_t)m * 1024, a.in[I_LN2], XN + (size_t)m * 1024, lane);
}
__device__ __forceinline__ void unpack8(v4u w, float* f) {
    f[0] = __uint_as_float(w.x << 16); f[1] = __uint_as_float(w.x & 0xffff0000u); f[2] = __uint_as_float(w.y << 16); f[3] = __uint_as_float(w.y & 0xffff0000u);
    f[4] = __uint_as_float(w.z << 16); f[5] = __uint_as_float(w.z & 0xffff0000u); f[6] = __uint_as_float(w.w << 16); f[7] = __uint_as_float(w.w & 0xffff0000u);
}
__device__ __forceinline__ void ph_conv(const Args& a, int gtid, int NT) {
    using namespace cfg;
    const bf16* Z = (const bf16*)(a.ws + WS_Z); bf16* ACT = (bf16*)(a.ws + WS_ACT);
    const float* cw = a.in[I_CONVW]; const float* cbias = a.in[I_CONVB]; const float* sconv = a.in[I_SCV];
    for (int it = gtid; it < M * 352; it += NT) {
        const int row = it / 352, c8 = (it - row * 352) * 8;
        float z[3][2][8];
#pragma unroll
        for (int j = 0; j < 3; ++j) {
            const int back = 2 - j;
            const bf16* zr = nullptr; const float* sr = nullptr;
            if (row < MPP) { if (row - back >= 0) zr = Z + (size_t)(row - back) * NUP; }
            else { const int d = row - MPP, t = d & 15, b = d >> 4; if (t - back >= 0) zr = Z + (size_t)(row - back) * NUP; else sr = sconv + ((size_t)b * 2 + (t - back + 2)) * NUP; }
#pragma unroll
            for (int hf = 0; hf < 2; ++hf) {
                if (zr) unpack8(*(const v4u*)(zr + hf * DFF + c8), z[j][hf]);
                else if (sr) { const f32x4 s0 = *(const f32x4*)(sr + hf * DFF + c8), s1 = *(const f32x4*)(sr + hf * DFF + c8 + 4); z[j][hf][0] = s0.x; z[j][hf][1] = s0.y; z[j][hf][2] = s0.z; z[j][hf][3] = s0.w; z[j][hf][4] = s1.x; z[j][hf][5] = s1.y; z[j][hf][6] = s1.z; z[j][hf][7] = s1.w; }
                else {
#pragma unroll
                    for (int e = 0; e < 8; ++e) z[j][hf][e] = 0.f; }
            }
        }
        float act[8];
#pragma unroll
        for (int e = 0; e < 8; ++e) {
            const int cg_ = c8 + e, cu = DFF + c8 + e;
            const float gt = cbias[cg_] + z[0][0][e] * cw[cg_] + z[1][0][e] * cw[NUP + cg_] + z[2][0][e] * cw[2 * NUP + cg_];
            const float up = cbias[cu] + z[0][1][e] * cw[cu] + z[1][1][e] * cw[NUP + cu] + z[2][1][e] * cw[2 * NUP + cu];
            act[e] = gt / (1.0f + expf(-gt)) * up;
        }
        v4u w; w.x = pk2(act[0], act[1]); w.y = pk2(act[2], act[3]); w.z = pk2(act[4], act[5]); w.w = pk2(act[6], act[7]);
        *(v4u*)(ACT + (size_t)row * DFF + c8) = w;
        float* cd = nullptr;
        if (row == MP - 2 || row == MP - 1) cd = a.out + O_CP + (size_t)(row - (MP - 2)) * NUP;
        else if (row >= MPP && ((row - MPP) & 15) >= 14) cd = a.out + O_CS + ((size_t)((row - MPP) >> 4) * 2 + (((row - MPP) & 15) - 14)) * NUP;
        if (cd) {
#pragma unroll
            for (int hf = 0; hf < 2; ++hf) { *(f32x4*)(cd + hf * DFF + c8) = (f32x4){z[2][hf][0], z[2][hf][1], z[2][hf][2], z[2][hf][3]}; *(f32x4*)(cd + hf * DFF + c8 + 4) = (f32x4){z[2][hf][4], z[2][hf][5], z[2][hf][6], z[2][hf][7]}; }
        }
    }
}

template <int PMASK> __global__ void __launch_bounds__(NWAVES * 64, 2) mk_fwd(Args args) {
    extern __shared__ __attribute__((aligned(16))) unsigned char lds_raw[];
    using namespace cfg;
    LAS unsigned char* lds = (LAS unsigned char*)lds_raw;
    volatile LAS unsigned* MISC = (volatile LAS unsigned*)(lds + MISC_OFF);
    const int tid = threadIdx.x, lane = tid & 63, wave = __builtin_amdgcn_readfirstlane(tid >> 6);
    const int G = gridDim.x, bx = blockIdx.x, vcu = (G % 8 == 0) ? (bx % 8) * (G / 8) + bx / 8 : bx;
    const int gw = vcu * NWAVES + wave, NGW = G * NWAVES;
    gu32* ctl = (gu32*)(args.ws + WS_CTL);
    for (int u = tid; u < (LDS_BYTES - LDSCTL_OFF) / 4; u += NWAVES * 64) ((LAS unsigned*)(lds + LDSCTL_OFF))[u] = 0u;
    __syncthreads();
    XcdBarrier bar; bar.bar = (unsigned*)(ctl + CW_BAR) + args.li * XCD_BAR_WORDS; bar.x = 0; bar.st = nullptr;
    if (N_LAUNCHES != N_PHASES) bar = xcd_barrier_post((unsigned*)(ctl + CW_BAR) + args.li * XCD_BAR_WORDS, MISC + 8);
#define GRID_BAR() do { if (N_LAUNCHES != N_PHASES) xcd_barrier(bar); } while (0)
    const int lo = args.ph_lo, hi = args.ph_hi;
#define IN(k) (((PMASK >> (k)) & 1) && lo <= (k) && (k) < hi)
#define BOTH(k) (IN(k) && IN((k) + 1))
#define LAMBDA() (expf(wave_sum(args.in[I_LQ1][lane] * args.in[I_LK1][lane])) - expf(wave_sum(args.in[I_LQ2][lane] * args.in[I_LK2][lane])) + LAM_INIT)

    if (IN(0)) { ph_prologue(args, lds, gw, NGW, wave, lane); if (BOTH(0)) GRID_BAR(); }
    if (IN(1)) {
        pg8::Gemm g{(const pg8::bf16_t*)(args.ws + WS_XN), (const pg8::bf16_t*)(args.ws + WS_WIN), M, NPROJ, DM}; pg8::StaticOrder S; S.init(M, NPROJ, G, bx);
        pg8::EpiF32 E{(float*)(args.ws + WS_PROJ), NPROJ};
        pg8::gemm_phase<pg8::EpiF32, pg8::StaticOrder, true, true>(lds + RING_OFF, g, S, E);
        if (BOTH(1)) GRID_BAR();
    }
    if (IN(2)) { ph_rowpass(args, gw, NGW, lane); if (BOTH(2)) GRID_BAR(); }
    if (IN(3)) { ph_rwkv_prep(args, lds, vcu, G, tid, wave, lane); if (BOTH(3)) GRID_BAR(); }
    if (IN(4)) { ph_r1(args, gw, NGW, lane); if (BOTH(4)) GRID_BAR(); }
    if (IN(5)) { if (bx < 32) ph_r2(args, lds, bx, wave, lane); __syncthreads(); ph_dec_attn(args, lds, ctl, MISC, tid, wave, lane); if (BOTH(5)) GRID_BAR(); }
    if (IN(6)) { const float lam = LAMBDA(); ph_r3(args, gw, NGW, lane, lam); if (BOTH(6)) GRID_BAR(); }
    if (IN(7)) { const float lam = LAMBDA(); ph_attn(args, lds, ctl, MISC, lam, tid, wave, lane); if (BOTH(7)) GRID_BAR(); }
    if (IN(8)) {
        pg8::Gemm g{(const pg8::bf16_t*)(args.ws + WS_MIX), (const pg8::bf16_t*)(args.ws + WS_WOUT), M, DM, DM}; pg8::StaticOrder S; S.init(M, DM, G, bx);
        pg8::EpiX1 E{args.in[I_XP], args.in[I_XS], args.in[I_META], (float*)(args.ws + WS_X1)};
        pg8::gemm_phase<pg8::EpiX1, pg8::StaticOrder, true, true>(lds + RING_OFF, g, S, E);
        if (BOTH(8)) GRID_BAR();
    }
    if (IN(9)) { ph_norm2(args, gw, NGW, lane); if (BOTH(9)) GRID_BAR(); }
    if (IN(10)) {
        pg8::Gemm g{(const pg8::bf16_t*)(args.ws + WS_XN), (const pg8::bf16_t*)(args.ws + WS_WUP), M, NUP, DM}; pg8::StaticOrder S; S.init(M, NUP, G, bx);
        pg8::EpiBf E{(pg8::bf16_t*)(args.ws + WS_Z), NUP};
        pg8::gemm_phase<pg8::EpiBf, pg8::StaticOrder, true, true>(lds + RING_OFF, g, S, E);
        if (BOTH(10)) GRID_BAR();
    }
    if (IN(11)) { ph_conv(args, vcu * (NWAVES * 64) + tid, G * NWAVES * 64); if (BOTH(11)) GRID_BAR(); }
    if (IN(12)) {
        pg8::Gemm g{(const pg8::bf16_t*)(args.ws + WS_ACT), (const pg8::bf16_t*)(args.ws + WS_WDN), M, DM, DFF}; pg8::StaticOrder S; S.init(M, DM, G, bx);
        pg8::EpiY E{(const float*)(args.ws + WS_X1), args.out};
        pg8::gemm_phase<pg8::EpiY, pg8::StaticOrder, true, true>(lds + RING_OFF, g, S, E);
    }
#undef IN
#undef BOTH
#undef GRID_BAR
}


#ifndef PH_MASK
#define PH_MASK 0x1fff
#endif
template <int K> struct PhaseKernels {
    static hipError_t set_attr() { hipError_t e = hipFuncSetAttribute((const void*)mk_fwd<(1 << K)>, hipFuncAttributeMaxDynamicSharedMemorySize, LDS_BYTES); if (e != hipSuccess) return e; return PhaseKernels<K - 1>::set_attr(); }
    static void launch(int li, int grid, hipStream_t stream, const Args& a) { if (li == K) hipLaunchKernelGGL(mk_fwd<(1 << K)>, dim3(grid), dim3(NWAVES * 64), LDS_BYTES, stream, a); else PhaseKernels<K - 1>::launch(li, grid, stream, a); }
};
template <> struct PhaseKernels<-1> { static hipError_t set_attr() { return hipSuccess; } static void launch(int, int, hipStream_t, const Args&) {} };
static hipError_t set_lds_attr() {
    if constexpr (N_LAUNCHES == 1) return hipFuncSetAttribute((const void*)mk_fwd<PH_MASK>, hipFuncAttributeMaxDynamicSharedMemorySize, LDS_BYTES);
    else return PhaseKernels<N_PHASES - 1>::set_attr();
}
static void launch_one(int li, int grid, hipStream_t stream, const Args& a) {
    if constexpr (N_LAUNCHES == 1) hipLaunchKernelGGL(mk_fwd<PH_MASK>, dim3(grid), dim3(NWAVES * 64), LDS_BYTES, stream, a);
    else PhaseKernels<N_PHASES - 1>::launch(li, grid, stream, a);
}
extern "C" void kernel_launch(void* const* d_in, const int* in_sizes, int n_in, void* d_out, int out_size, void* d_ws, size_t ws_size, hipStream_t stream) {
    static int grid = 0;
    if (grid == 0) {
        if (n_in != 35 || out_size != (int)cfg::O_END || ws_size < WS_END) { fprintf(stderr, "kernel_launch: unexpected shapes: n_in %d out %d ws %zu (need %zu); nothing launched\n", n_in, out_size, ws_size, (size_t)WS_END); grid = -1; return; }
        int dev = 0, cus = 0;
        if (hipGetDevice(&dev) != hipSuccess || hipDeviceGetAttribute(&cus, hipDeviceAttributeMultiprocessorCount, dev) != hipSuccess) { fprintf(stderr, "kernel_launch: device query failed\n"); grid = -1; return; }
        if (set_lds_attr() != hipSuccess) { fprintf(stderr, "kernel_launch: hipFuncSetAttribute failed\n"); grid = -1; return; }
        (void)hipGetLastError();
        grid = cus;
        if (grid < 32) { fprintf(stderr, "kernel_launch: needs >= 32 CUs\n"); grid = -1; return; }
    }
    if (grid < 0) return;
    if (hipMemsetAsync((char*)d_ws + WS_CTL, 0, CTL_ZERO_BYTES, stream) != hipSuccess) { fprintf(stderr, "kernel_launch: memset failed\n"); return; }
    Args a{};
    for (int i = 0; i < 35; ++i) a.in[i] = (const float*)d_in[i];
    a.out = (float*)d_out; a.ws = (unsigned char*)d_ws;
    static_assert(N_LAUNCHES == 1 || N_LAUNCHES == N_PHASES, "MK_N_LAUNCHES: 1 or 13");
    for (int li = 0; li < N_LAUNCHES; ++li) {
        a.ph_lo = (N_LAUNCHES == 1) ? 0 : li; a.ph_hi = (N_LAUNCHES == 1) ? N_PHASES : li + 1; a.li = (N_LAUNCHES == 1) ? 0 : 0;
        launch_one(li, grid, stream, a);
        const hipError_t le = hipPeekAtLastError();
        if (le != hipSuccess) { fprintf(stderr, "kernel_launch: launch %d failed: %s\n", li, hipGetErrorName(le)); break; }
    }
}
```

```cpp
#include <hip/hip_runtime.h>
#include <hip/hip_bf16.h>
#include <cstdio>
#include <cstdint>
#include <cmath>

#ifndef R3_MODE
#define R3_MODE 3
#endif
#ifndef MK_N_LAUNCHES
#define MK_N_LAUNCHES 1
#endif

namespace cfg {
constexpr int DM = 1024, SEQ = 16384, NMETA = 16, FPAD = 48;
constexpr int MP = FPAD + NMETA + SEQ;
constexpr int MPP = 16640;
constexpr int DB = 32, DT = 16, MD = DB * DT;
constexpr int M = MPP + MD;
constexpr int NCK = 4112;
constexpr int DA = 512, NPR = 1792, NPROJ = 3328, DFF = 2816, NUP = 5632, PR0 = 1536;
constexpr int NCH = 257;
constexpr int NT64 = 265;
constexpr float NORM_EPS = 1e-6f, GN_EPS = 64e-5f, LAM_INIT = 0.2f;
constexpr float QSCALE = 0.125f * 1.4426950408889634f;
constexpr size_t O_YP = 0, O_YS = O_YP + (size_t)SEQ * DM, O_KP = O_YS + (size_t)MD * DM, O_VP = O_KP + (size_t)(NMETA + SEQ) * 512,
    O_SP = O_VP + (size_t)(NMETA + SEQ) * 512, O_HP = O_SP + 8 * 4096, O_CP = O_HP + NPR, O_KS = O_CP + 2 * NUP, O_VS = O_KS + (size_t)MD * 512,
    O_SS = O_VS + (size_t)MD * 512, O_HS = O_SS + (size_t)DB * 8 * 4096, O_CS = O_HS + (size_t)DB * NPR, O_END = O_CS + (size_t)DB * 2 * NUP;
static_assert(O_END == 36131584, "output size");
}
namespace pg8 {
#define PG8_LAS __attribute__((address_space(3)))
typedef unsigned short bf16_t;
typedef short bf16x8 __attribute__((ext_vector_type(8)));
typedef float f32x4 __attribute__((ext_vector_type(4)));
typedef unsigned u32x4 __attribute__((ext_vector_type(4)));
constexpr int BM = 256, BK = 64, HALF = 128, HTB = HALF * BK * 2  , STAGE_BYTES = 8 * HTB, NXCD = 8, WGM = 8;

__host__ __device__ __forceinline__ int lds_byte(int r, int c) { const int st = (r >> 4) * 2 + (c >> 5), rr = r & 15, cc = c & 31, ob = rr * 64 + cc * 2; return st * 1024 + (ob ^ (((ob >> 9) & 1) << 5)); }
__host__ __device__ __forceinline__ void stage_rc(int b, int& R, int& C) { const int st = b / 1024, sb = b % 1024, swz = sb ^ (((sb >> 9) & 1) << 5); R = (st >> 1) * 16 + swz / 64; C = (st & 1) * 32 + (swz % 64) / 2; }
__host__ __device__ __forceinline__ int perm32(int rho) { const int n = rho >> 4, i = rho & 15; return 8 * (i >> 2) + 4 * n + (i & 3); }

struct Unit { int pm, pn; };
struct Gemm { const bf16_t* A; const bf16_t* Bt; int M, N, K; };

struct StaticOrder {
    int nM, nN, nwg, G, c;
    __host__ __device__ void init(int M, int N, int G_, int c_) { nM = M / BM; nN = N / BM; nwg = nM * nN; G = G_; c = c_; }
    __host__ __device__ bool next(int i, Unit& u) const {
        const long L = (long)i * G + c; if (L >= nwg) return false;
        int wgid = (int)L; { const int q = nwg / NXCD, r = nwg % NXCD, xcd = wgid % NXCD, off = wgid / NXCD; wgid = (xcd < r ? xcd * (q + 1) : r * (q + 1) + (xcd - r) * q) + off; }
        const int nig = WGM * nN, gid = wgid / nig, fm = gid * WGM, gsz = (nM - fm) < WGM ? (nM - fm) : WGM;
        u.pm = fm + ((wgid % nig) % gsz); u.pn = (wgid % nig) / gsz; return true;
    }
    __device__ __forceinline__ void a_ready(const Unit&) const {}
    __device__ __forceinline__ void done(const Unit&) const {}
};

__device__ __forceinline__ unsigned cvt_pk_bf16(float lo, float hi) { unsigned r; asm volatile("v_cvt_pk_bf16_f32 %0, %1, %2" : "=v"(r) : "v"(lo), "v"(hi)); return r; }
typedef float f32x2 __attribute__((ext_vector_type(2)));

__device__ __forceinline__ const float* x_src_row(int r, const float* xp, const float* xs, const float* meta) {
    using namespace cfg;
    if (r < FPAD) return nullptr;
    if (r < FPAD + NMETA) return meta + (size_t)(r - FPAD) * DM;
    if (r < MP) return xp + (size_t)(r - FPAD - NMETA) * DM;
    if (r < MPP) return nullptr;
    return xs + (size_t)(r - MPP) * DM;
}
struct EpiF32 {
    static constexpr bool PERM = false, AFTER_DRAIN = false;
    float* O; int ldc;
    __device__ __forceinline__ void operator()(const f32x4 (&acc)[2][2][4][2], const Unit& u, int wr, int wc, int fr, int fq) const {
        const int row0 = u.pm * BM + wr * 64 + fr, col0 = u.pn * BM + wc * 32 + 4 * fq;
#pragma unroll
        for (int ai = 0; ai < 2; ++ai)
#pragma unroll
            for (int m = 0; m < 4; ++m) { float* rowp = O + (size_t)(row0 + ai * HALF + m * 16) * ldc + col0;
#pragma unroll
                for (int bj = 0; bj < 2; ++bj)
#pragma unroll
                    for (int n = 0; n < 2; ++n) *(f32x4*)(rowp + bj * HALF + n * 16) = acc[ai][bj][m][n]; }
    }
};
struct EpiX1 {
    static constexpr bool PERM = false, AFTER_DRAIN = false;
    const float* xp; const float* xs; const float* meta; float* X1; bf16_t* XB; unsigned long long* SSQ; const float* gain;
    __device__ __forceinline__ void operator()(const f32x4 (&acc)[2][2][4][2], const Unit& u, int wr, int wc, int fr, int fq) const {
        const int row0 = u.pm * BM + wr * 64 + fr, col0 = u.pn * BM + wc * 32 + 4 * fq;
        f32x4 gv[2][2];
#pragma unroll
        for (int bj = 0; bj < 2; ++bj)
#pragma unroll
            for (int n = 0; n < 2; ++n) gv[bj][n] = *(const f32x4*)(gain + col0 + bj * HALF + n * 16);
#pragma unroll
        for (int ai = 0; ai < 2; ++ai)
#pragma unroll
            for (int m = 0; m < 4; ++m) { const int r = row0 + ai * HALF + m * 16; const float* src = x_src_row(r, xp, xs, meta); float* rowp = X1 + (size_t)r * cfg::DM + col0; bf16_t* rowb = XB + (size_t)r * cfg::DM + col0;
                float ss = 0.f;
#pragma unroll
                for (int bj = 0; bj < 2; ++bj)
#pragma unroll
                    for (int n = 0; n < 2; ++n) { f32x4 v = (f32x4){0.f, 0.f, 0.f, 0.f}; if (src) v = *(const f32x4*)(src + col0 + bj * HALF + n * 16) + acc[ai][bj][m][n];
                        *(f32x4*)(rowp + bj * HALF + n * 16) = v; ss += (v[0] * v[0] + v[1] * v[1]) + (v[2] * v[2] + v[3] * v[3]);
                        const f32x4 vg = v * gv[bj][n]; f32x2 w; ((unsigned*)&w)[0] = cvt_pk_bf16(vg[0], vg[1]); ((unsigned*)&w)[1] = cvt_pk_bf16(vg[2], vg[3]); *(f32x2*)(rowb + bj * HALF + n * 16) = w; }
                ss += __shfl_xor(ss, 16); ss += __shfl_xor(ss, 32);
                if (fq == 0 && src) (void)__hip_atomic_fetch_add(SSQ + r, (unsigned long long)(ss * 16777216.0f), __ATOMIC_RELAXED, __HIP_MEMORY_SCOPE_AGENT); }
    }
};
struct EpiBfS {
    static constexpr bool PERM = true, AFTER_DRAIN = false;
    bf16_t* O; int ldc; const unsigned long long* SSQ;
    __device__ __forceinline__ void operator()(const f32x4 (&acc)[2][2][4][2], const Unit& u, int wr, int wc, int fr, int fq) const {
        const int row0 = u.pm * BM + wr * 64 + fr, col0 = u.pn * BM + wc * 32 + 8 * fq;
#pragma unroll
        for (int ai = 0; ai < 2; ++ai)
#pragma unroll
            for (int m = 0; m < 4; ++m) { const int r = row0 + ai * HALF + m * 16; bf16_t* rowp = O + (size_t)r * ldc + col0;
                const float rs = 1.0f / sqrtf((float)SSQ[r] * (1.0f / 16777216.0f / 1024.0f) + cfg::NORM_EPS);
#pragma unroll
                for (int bj = 0; bj < 2; ++bj) { const f32x4 v0 = acc[ai][bj][m][0] * rs, v1 = acc[ai][bj][m][1] * rs;
                    u32x4 w; w.x = cvt_pk_bf16(v0[0], v0[1]); w.y = cvt_pk_bf16(v0[2], v0[3]); w.z = cvt_pk_bf16(v1[0], v1[1]); w.w = cvt_pk_bf16(v1[2], v1[3]);
                    *(u32x4*)(rowp + bj * HALF) = w; } }
    }
};
struct EpiConv {
    static constexpr bool PERM = true, AFTER_DRAIN = false;
    bf16_t* Z; bf16_t* ACT; const unsigned long long* SSQ; const float* cw; const float* cb; float* out;
#define PG8_DPPU(oldv, src, ctrl) ((unsigned)__builtin_amdgcn_update_dpp((int)(oldv), (int)(src), (ctrl), 0xF, 0xF, false))
    __device__ __forceinline__ void operator()(const f32x4 (&acc)[2][2][4][2], const Unit& u, int wr, int wc, int fr, int fq) const {
        using namespace cfg;
        const int row0 = u.pm * BM + wr * 64 + fr, f0 = u.pn * 128 + wc * 32 + 8 * fq;
        const bool dectile = u.pm * BM >= MPP;
        unsigned zp[2][2][4][4];
#pragma unroll
        for (int ai = 0; ai < 2; ++ai)
#pragma unroll
            for (int m = 0; m < 4; ++m) { const int r = row0 + ai * HALF + m * 16;
                const float rs = __builtin_amdgcn_rsqf((float)SSQ[r] * (1.0f / 16777216.0f / 1024.0f) + NORM_EPS);
                const bool bnd = dectile ? (fr < 2 || fr >= 14) : ((m == 0 && fr < 2) || (m == 3 && fr >= 14));
                bf16_t* rowp = Z + (size_t)r * NUP + u.pn * BM + wc * 32 + 8 * fq;
                float* cd = nullptr;
                if (fr >= 14) { if (r == MP - 16 + fr) cd = out + O_CP + (size_t)(fr - 14) * NUP; else if (r >= MPP) cd = out + O_CS + ((size_t)((r - MPP) >> 4) * 2 + (fr - 14)) * NUP; }
#pragma unroll
                for (int bj = 0; bj < 2; ++bj) { const f32x4 v0 = acc[ai][bj][m][0] * rs, v1 = acc[ai][bj][m][1] * rs;
                    zp[ai][bj][m][0] = cvt_pk_bf16(v0[0], v0[1]); zp[ai][bj][m][1] = cvt_pk_bf16(v0[2], v0[3]); zp[ai][bj][m][2] = cvt_pk_bf16(v1[0], v1[1]); zp[ai][bj][m][3] = cvt_pk_bf16(v1[2], v1[3]);
                    if (bnd) { u32x4 w; w.x = zp[ai][bj][m][0]; w.y = zp[ai][bj][m][1]; w.z = zp[ai][bj][m][2]; w.w = zp[ai][bj][m][3]; *(u32x4*)(rowp + bj * HALF) = w; }
                    if (cd) { *(f32x4*)(cd + bj * DFF + f0) = v0; *(f32x4*)(cd + bj * DFF + f0 + 4) = v1; } }
            }
        float w[2][3][8], bb[2][8];
#pragma unroll
        for (int bj = 0; bj < 2; ++bj) { const f32x4 b0 = *(const f32x4*)(cb + bj * DFF + f0), b1 = *(const f32x4*)(cb + bj * DFF + f0 + 4);
            bb[bj][0] = b0[0]; bb[bj][1] = b0[1]; bb[bj][2] = b0[2]; bb[bj][3] = b0[3]; bb[bj][4] = b1[0]; bb[bj][5] = b1[1]; bb[bj][6] = b1[2]; bb[bj][7] = b1[3];
#pragma unroll
            for (int j = 0; j < 3; ++j) { const f32x4 w0 = *(const f32x4*)(cw + (size_t)j * NUP + bj * DFF + f0), w1 = *(const f32x4*)(cw + (size_t)j * NUP + bj * DFF + f0 + 4);
                w[bj][j][0] = w0[0]; w[bj][j][1] = w0[1]; w[bj][j][2] = w0[2]; w[bj][j][3] = w0[3]; w[bj][j][4] = w1[0]; w[bj][j][5] = w1[1]; w[bj][j][6] = w1[2]; w[bj][j][7] = w1[3]; } }
#pragma unroll
        for (int ai = 0; ai < 2; ++ai)
#pragma unroll
            for (int m = 0; m < 4; ++m) { const int r = row0 + ai * HALF + m * 16; float cv[2][8];
#pragma unroll
                for (int bj = 0; bj < 2; ++bj)
#pragma unroll
                    for (int p = 0; p < 4; ++p) { const unsigned cur = zp[ai][bj][m][p], prv = zp[ai][bj][m > 0 ? m - 1 : 0][p];
                        const unsigned z1 = PG8_DPPU((unsigned)__builtin_amdgcn_mov_dpp((int)prv, 0x121, 0xF, 0xF, false), cur, 0x111);
                        const unsigned z2 = PG8_DPPU((unsigned)__builtin_amdgcn_mov_dpp((int)prv, 0x122, 0xF, 0xF, false), cur, 0x112);
#pragma unroll
                        for (int h = 0; h < 2; ++h) { const int e = 2 * p + h;
                            const float c0 = __builtin_bit_cast(float, h ? (cur & 0xffff0000u) : (cur << 16)), c1 = __builtin_bit_cast(float, h ? (z1 & 0xffff0000u) : (z1 << 16)), c2 = __builtin_bit_cast(float, h ? (z2 & 0xffff0000u) : (z2 << 16));
                            cv[bj][e] = bb[bj][e] + c2 * w[bj][0][e] + c1 * w[bj][1][e] + c0 * w[bj][2][e]; } }
                float a8[8];
#pragma unroll
                for (int e = 0; e < 8; ++e) { const float g = cv[0][e]; a8[e] = g * __builtin_amdgcn_rcpf(1.0f + __builtin_amdgcn_exp2f(-1.4426950408889634f * g)) * cv[1][e]; }
                u32x4 wo; wo.x = cvt_pk_bf16(a8[0], a8[1]); wo.y = cvt_pk_bf16(a8[2], a8[3]); wo.z = cvt_pk_bf16(a8[4], a8[5]); wo.w = cvt_pk_bf16(a8[6], a8[7]);
                *(u32x4*)(ACT + (size_t)r * DFF + f0) = wo; }
    }
};
struct EpiBf {
    static constexpr bool PERM = true, AFTER_DRAIN = false;
    bf16_t* O; int ldc;
    __device__ __forceinline__ void operator()(const f32x4 (&acc)[2][2][4][2], const Unit& u, int wr, int wc, int fr, int fq) const {
        const int row0 = u.pm * BM + wr * 64 + fr, col0 = u.pn * BM + wc * 32 + 8 * fq;
#pragma unroll
        for (int ai = 0; ai < 2; ++ai)
#pragma unroll
            for (int m = 0; m < 4; ++m) { bf16_t* rowp = O + (size_t)(row0 + ai * HALF + m * 16) * ldc + col0;
#pragma unroll
                for (int bj = 0; bj < 2; ++bj) { const f32x4 v0 = acc[ai][bj][m][0], v1 = acc[ai][bj][m][1];
                    u32x4 w; w.x = cvt_pk_bf16(v0[0], v0[1]); w.y = cvt_pk_bf16(v0[2], v0[3]); w.z = cvt_pk_bf16(v1[0], v1[1]); w.w = cvt_pk_bf16(v1[2], v1[3]);
                    *(u32x4*)(rowp + bj * HALF) = w; } }
    }
};
struct EpiY {
    static constexpr bool PERM = false, AFTER_DRAIN = false;
    const float* X1; float* out;
    __device__ __forceinline__ void operator()(const f32x4 (&acc)[2][2][4][2], const Unit& u, int wr, int wc, int fr, int fq) const {
        using namespace cfg;
        const int row0 = u.pm * BM + wr * 64 + fr, col0 = u.pn * BM + wc * 32 + 4 * fq;
#pragma unroll
        for (int ai = 0; ai < 2; ++ai)
#pragma unroll
            for (int m = 0; m < 4; ++m) { const int r = row0 + ai * HALF + m * 16;
                float* dst = nullptr;
                if (r >= FPAD + NMETA && r < MP) dst = out + O_YP + (size_t)(r - FPAD - NMETA) * DM; else if (r >= MPP) dst = out + O_YS + (size_t)(r - MPP) * DM;
                if (dst) { const float* xr = X1 + (size_t)r * DM + col0;
#pragma unroll
                    for (int bj = 0; bj < 2; ++bj)
#pragma unroll
                        for (int n = 0; n < 2; ++n) *(f32x4*)(dst + col0 + bj * HALF + n * 16) = *(const f32x4*)(xr + bj * HALF + n * 16) + acc[ai][bj][m][n]; } }
    }
};

template <class Epi, class Sched, bool ALIGN_EPI = false, bool SP2 = false>
__device__ __forceinline__ void gemm_phase(PG8_LAS unsigned char* lds, const Gemm g, const Sched& S, const Epi& E) {
    const int tid = threadIdx.x, wid = __builtin_amdgcn_readfirstlane(tid >> 6), lane = tid & 63, wr = wid >> 2, wc = wid & 3, fr = lane & 15, fq = lane >> 4;
    const int K = g.K, nt = K / BK;
    unsigned voffA[2], voffB[2];
#pragma unroll
    for (int i = 0; i < 2; ++i) { int R, C; stage_rc(tid * 16 + i * 8192, R, C); const int Rb = Epi::PERM ? ((R & ~31) + perm32(R & 31)) : R;
        voffA[i] = (unsigned)(R * K + C) * 2u; voffB[i] = (unsigned)(Rb * K + C) * 2u; }
    const size_t kstep = (size_t)(BK * 2);
    const size_t hstep = (size_t)HALF * K * 2;
    const size_t tstep = 2 * hstep;
    const unsigned ldsw = (unsigned)wid * 1024u;
    const int aoff = lds_byte(wr * 64 + fr, fq * 8), boff = lds_byte(wc * 32 + fr, fq * 8);
#define PG8_SA(b, h) (((b) * 2 + (h)) * HTB)
#define PG8_SB(b, h) ((4 + (b) * 2 + (h)) * HTB)
#define PG8_STAGE(bufoff, gbase, voff) do { _Pragma("unroll") for (int _i = 0; _i < 2; ++_i) \
        __builtin_amdgcn_global_load_lds((const unsigned*)((const char*)(gbase) + (voff)[_i]), (PG8_LAS unsigned*)(lds + (bufoff) + ldsw + _i * 8192), 16, 0, 0); } while (0)
#define PG8_LDA(dst, b, h) do { _Pragma("unroll") for (int m = 0; m < 4; ++m) _Pragma("unroll") for (int k = 0; k < 2; ++k) dst[m][k] = *(const PG8_LAS bf16x8*)(lds + PG8_SA(b, h) + aoff + m * 2048 + k * 1024); } while (0)
#define PG8_LDB(dst, b, h) do { _Pragma("unroll") for (int n = 0; n < 2; ++n) _Pragma("unroll") for (int k = 0; k < 2; ++k) dst[n][k] = *(const PG8_LAS bf16x8*)(lds + PG8_SB(b, h) + boff + n * 2048 + k * 1024); } while (0)
#define PG8_MMA(ai, bj, At, Bt) do { __builtin_amdgcn_s_setprio(1); _Pragma("unroll") for (int m = 0; m < 4; ++m) _Pragma("unroll") for (int n = 0; n < 2; ++n) _Pragma("unroll") for (int k = 0; k < 2; ++k) \
        acc[ai][bj][m][n] = __builtin_amdgcn_mfma_f32_16x16x32_bf16(Bt[n][k], At[m][k], acc[ai][bj][m][n], 0, 0, 0); __builtin_amdgcn_s_setprio(0); } while (0)
#define PG8_WAIT_V(n) asm volatile("s_waitcnt vmcnt(" #n ")" ::: "memory")
#define PG8_WAIT_L(n) asm volatile("s_waitcnt lgkmcnt(" #n ")" ::: "memory")
#define PG8_BAR __builtin_amdgcn_s_barrier()
#define PG8_SCHED __builtin_amdgcn_sched_barrier(0)
    Unit cur, nxt; int ui = 0;
    if (!S.next(0, cur)) return;
    f32x4 acc[2][2][4][2];
#pragma unroll
    for (int a = 0; a < 2; ++a)
#pragma unroll
        for (int b = 0; b < 2; ++b)
#pragma unroll
            for (int m = 0; m < 4; ++m)
#pragma unroll
                for (int n = 0; n < 2; ++n) acc[a][b][m][n] = (f32x4){0.f, 0.f, 0.f, 0.f};
    bf16x8 At[4][2], B0[2][2], B1[2][2];
    const char* cA = (const char*)g.A + (size_t)cur.pm * tstep; const char* cB = (const char*)g.Bt + (size_t)cur.pn * tstep;
    S.a_ready(cur);
    if constexpr (SP2) {
        PG8_STAGE(PG8_SB(0, 0), cB, voffB); PG8_STAGE(PG8_SB(0, 1), cB + hstep, voffB); PG8_STAGE(PG8_SA(0, 0), cA, voffA); PG8_STAGE(PG8_SA(0, 1), cA + hstep, voffA);
        if (wr == 1) PG8_BAR;
        PG8_WAIT_V(2); PG8_BAR;
        PG8_STAGE(PG8_SB(1, 0), cB + kstep, voffB); PG8_STAGE(PG8_SA(1, 0), cA + kstep, voffA); PG8_STAGE(PG8_SB(1, 1), cB + hstep + kstep, voffB);
        PG8_WAIT_V(6); PG8_BAR;
    } else {
        PG8_STAGE(PG8_SB(0, 0), cB, voffB); PG8_STAGE(PG8_SA(0, 0), cA, voffA); PG8_STAGE(PG8_SB(0, 1), cB + hstep, voffB); PG8_STAGE(PG8_SA(0, 1), cA + hstep, voffA);
        if (wr == 1) PG8_BAR;
        PG8_WAIT_V(4); PG8_BAR;
        PG8_STAGE(PG8_SB(1, 0), cB + kstep, voffB); PG8_STAGE(PG8_SA(1, 0), cA + kstep, voffA); PG8_STAGE(PG8_SB(1, 1), cB + hstep + kstep, voffB);
        PG8_WAIT_V(6); PG8_BAR;
    }
    for (;;) {
        const bool has_next = S.next(ui + 1, nxt);
        const char* nA = has_next ? (const char*)g.A + (size_t)nxt.pm * tstep : cA; const char* nB = has_next ? (const char*)g.Bt + (size_t)nxt.pn * tstep : cB;
        for (int t = 0; t < nt; t += 2) {
            const bool last = (t == nt - 2);
            const char* a1 = cA + (size_t)(t + 1) * kstep;
            const char* a2 = last ? nA : cA + (size_t)(t + 2) * kstep; const char* b2 = last ? nB : cB + (size_t)(t + 2) * kstep;
            const char* a3 = a2 + kstep; const char* b3 = b2 + kstep;
            if (last && has_next) S.a_ready(nxt);
            if constexpr (SP2) {
            PG8_LDB(B0, 0, 0); PG8_LDB(B1, 0, 1); PG8_SCHED; PG8_LDA(At, 0, 0); PG8_STAGE(PG8_SA(1, 1), a1 + hstep, voffA);
            PG8_WAIT_V(8); PG8_WAIT_L(0); PG8_BAR; PG8_MMA(0, 0, At, B0); PG8_MMA(0, 1, At, B1); PG8_BAR; PG8_SCHED;
            PG8_LDA(At, 0, 1); PG8_STAGE(PG8_SB(0, 0), b2, voffB); PG8_STAGE(PG8_SB(0, 1), b2 + hstep, voffB); PG8_STAGE(PG8_SA(0, 0), a2, voffA);
            PG8_WAIT_V(8); PG8_WAIT_L(0); PG8_BAR; PG8_MMA(1, 0, At, B0); PG8_MMA(1, 1, At, B1); PG8_BAR; PG8_SCHED;
            PG8_LDB(B0, 1, 0); PG8_LDB(B1, 1, 1); PG8_SCHED; PG8_LDA(At, 1, 0); PG8_STAGE(PG8_SA(0, 1), a2 + hstep, voffA);
            PG8_WAIT_V(8); PG8_WAIT_L(0); PG8_BAR; PG8_MMA(0, 0, At, B0); PG8_MMA(0, 1, At, B1); PG8_BAR; PG8_SCHED;
            PG8_LDA(At, 1, 1); PG8_STAGE(PG8_SB(1, 0), b3, voffB); PG8_STAGE(PG8_SB(1, 1), b3 + hstep, voffB); PG8_STAGE(PG8_SA(1, 0), a3, voffA);
            PG8_WAIT_V(8); PG8_WAIT_L(0); PG8_BAR; PG8_MMA(1, 0, At, B0); PG8_MMA(1, 1, At, B1); PG8_BAR; PG8_SCHED;
            } else {
            PG8_LDB(B0, 0, 0); PG8_SCHED; PG8_LDA(At, 0, 0); PG8_STAGE(PG8_SA(1, 1), a1 + hstep, voffA);
            PG8_WAIT_L(8); PG8_BAR; PG8_WAIT_L(0); PG8_MMA(0, 0, At, B0); PG8_BAR; PG8_SCHED;
            PG8_LDB(B1, 0, 1); PG8_STAGE(PG8_SB(0, 0), b2, voffB);
            PG8_BAR; PG8_WAIT_L(0); PG8_MMA(0, 1, At, B1); PG8_BAR;
            PG8_LDA(At, 0, 1); PG8_STAGE(PG8_SA(0, 0), a2, voffA);
            PG8_BAR; PG8_WAIT_L(0); PG8_MMA(1, 0, At, B0); PG8_BAR; PG8_SCHED;
            PG8_STAGE(PG8_SB(0, 1), b2 + hstep, voffB);
            PG8_WAIT_V(6); PG8_BAR; PG8_MMA(1, 1, At, B1); PG8_BAR;
            PG8_LDB(B0, 1, 0); PG8_SCHED; PG8_LDA(At, 1, 0); PG8_STAGE(PG8_SA(0, 1), a2 + hstep, voffA);
            PG8_WAIT_L(8); PG8_BAR; PG8_WAIT_L(0); PG8_MMA(0, 0, At, B0); PG8_BAR; PG8_SCHED;
            PG8_LDB(B1, 1, 1); PG8_STAGE(PG8_SB(1, 0), b3, voffB);
            PG8_BAR; PG8_WAIT_L(0); PG8_MMA(0, 1, At, B1); PG8_BAR;
            PG8_LDA(At, 1, 1); PG8_STAGE(PG8_SA(1, 0), a3, voffA);
            PG8_BAR; PG8_WAIT_L(0); PG8_MMA(1, 0, At, B0); PG8_BAR; PG8_SCHED;
            PG8_STAGE(PG8_SB(1, 1), b3 + hstep, voffB);
            PG8_WAIT_V(6); PG8_BAR; PG8_MMA(1, 1, At, B1); PG8_BAR;
            }
        }
        if constexpr (ALIGN_EPI) { if (wr == 0) PG8_BAR; }
        if constexpr (!Epi::AFTER_DRAIN) { E(acc, cur, wr, wc, fr, fq); S.done(cur); }
        if (!has_next) break;
#pragma unroll
        for (int a = 0; a < 2; ++a)
#pragma unroll
            for (int b = 0; b < 2; ++b)
#pragma unroll
                for (int m = 0; m < 4; ++m)
#pragma unroll
                    for (int n = 0; n < 2; ++n) acc[a][b][m][n] = (f32x4){0.f, 0.f, 0.f, 0.f};
        cur = nxt; cA = nA; cB = nB; ++ui;
        if constexpr (ALIGN_EPI) { if (wr == 1) PG8_BAR; }
    }
    PG8_WAIT_V(0);
    if constexpr (!ALIGN_EPI) { if (wr == 0) PG8_BAR; }
    PG8_BAR;
    if constexpr (Epi::AFTER_DRAIN) { E.fused(acc, cur, wr, wc, fr, fq, lds, wid, lane); S.done(cur); }
#undef PG8_SA
#undef PG8_SB
#undef PG8_STAGE
#undef PG8_LDA
#undef PG8_LDB
#undef PG8_MMA
#undef PG8_WAIT_V
#undef PG8_WAIT_L
#undef PG8_BAR
#undef PG8_SCHED
}
}
#define GAS __attribute__((address_space(1)))
#define LAS __attribute__((address_space(3)))
typedef unsigned short bf16;
typedef unsigned v4u __attribute__((ext_vector_type(4)));
typedef float f32x4 __attribute__((ext_vector_type(4)));
typedef short bf16x8 __attribute__((ext_vector_type(8)));
typedef GAS unsigned gu32;
typedef GAS unsigned long long gu64;
#define RLX_AGENT __ATOMIC_RELAXED, __HIP_MEMORY_SCOPE_AGENT
#define LDS_WAIT() asm volatile("s_waitcnt lgkmcnt(0)" ::: "memory")
#define VM_WAIT() asm volatile("s_waitcnt vmcnt(0)" ::: "memory")
__device__ __forceinline__ unsigned long long rt() { return __builtin_amdgcn_s_memrealtime(); }
__device__ __forceinline__ unsigned f2bf(float f) { unsigned u = __builtin_bit_cast(unsigned, f); return (u + 0x7fffu + ((u >> 16) & 1u)) >> 16; }
typedef float f32x2_t __attribute__((ext_vector_type(2))); typedef __bf16 bf16x2_t __attribute__((ext_vector_type(2)));
__device__ __forceinline__ unsigned pk2(float lo, float hi) { f32x2_t v = {lo, hi}; bf16x2_t b = __builtin_convertvector(v, bf16x2_t); return __builtin_bit_cast(unsigned, b); }

#define XB_TMO      128
#define XB_XCNT(j)  (256  + 64 * (j))
#define XB_XSUB(j)  (1280 + 64 * (j))
#define XB_XGEN(j)  (2304 + 64 * (j))
#define XB_TOP      3328
#define XB_TOPGEN   3392
#define XCD_BAR_WORDS 3456
#define XB_SPIN_CAP (1u << 18)

__device__ __forceinline__ unsigned xb_ld(unsigned* p)              { return __hip_atomic_load(p, __ATOMIC_RELAXED, __HIP_MEMORY_SCOPE_AGENT); }
__device__ __forceinline__ unsigned xb_add(unsigned* p, unsigned v) { return __hip_atomic_fetch_add(p, v, __ATOMIC_RELAXED, __HIP_MEMORY_SCOPE_AGENT); }
__device__ __forceinline__ unsigned xb_xcc_id() { return (unsigned)__builtin_amdgcn_s_getreg((3 << 11) | 20) & 0xFu; }
#define XB_SPIN(cond, bar) do { unsigned _sp = 0; while (cond) { __builtin_amdgcn_s_sleep(1); \
    if ((++_sp & 255u) == 0u) { if (xb_ld(&(bar)[XB_TMO])) break; if (_sp > XB_SPIN_CAP) { atomicAdd(&(bar)[XB_TMO], 1u); break; } } } } while (0)

struct XcdBarrier {
    unsigned* bar; unsigned x;
    volatile LAS unsigned* st;
};

__device__ __forceinline__ XcdBarrier xcd_barrier_post(unsigned* bar, volatile LAS unsigned* st) {
    XcdBarrier b; b.bar = bar; b.x = xb_xcc_id(); b.st = st;
    if (threadIdx.x == 0) (void)xb_add(&bar[XB_XCNT(b.x)], 1u);
    return b;
}
__device__ __forceinline__ void xcd_barrier_complete(unsigned* bar, unsigned x, unsigned& nloc, unsigned& nx) {
    const unsigned G = gridDim.x * gridDim.y * gridDim.z;
    unsigned sum, cnt, mine, sp = 0u;
    for (;;) {
        sum = 0u; cnt = 0u; mine = 0u;
#pragma unroll
        for (unsigned j = 0; j < 16; ++j) { const unsigned c = xb_ld(&bar[XB_XCNT(j)]); sum += c; cnt += (c > 0u) ? 1u : 0u; mine = (j == x) ? c : mine; }
        if (sum == G) break;
        __builtin_amdgcn_s_sleep(1);
        if ((++sp & 255u) == 0u) { if (xb_ld(&bar[XB_TMO])) break; if (sp > XB_SPIN_CAP) { atomicAdd(&bar[XB_TMO], 1u); break; } }
    }
    nloc = mine > 0u ? mine : 1u; nx = cnt > 0u ? cnt : 1u;
}

__device__ __forceinline__ void xcd_barrier(const XcdBarrier& b) {
    asm volatile("s_waitcnt vmcnt(0)" ::: "memory");
    __syncthreads();
    if (threadIdx.x == 0) {
        unsigned* bar = b.bar;
        __builtin_amdgcn_s_waitcnt(0);
        unsigned nloc = b.st[0], nx = b.st[1];
        if (nloc == 0u) { xcd_barrier_complete(bar, b.x, nloc, nx); b.st[0] = nloc; b.st[1] = nx; }
        const unsigned old = xb_add(&bar[XB_XSUB(b.x)], 1u);
        const unsigned gen = old / nloc;
        if (old + 1u == (gen + 1u) * nloc) {
            __builtin_amdgcn_fence(__ATOMIC_RELEASE, "agent");
            asm volatile("s_waitcnt vmcnt(0)" ::: "memory");
            const unsigned og = xb_add(&bar[XB_TOP], 1u);
            const unsigned tg = og / nx;
            if (og + 1u == (tg + 1u) * nx) xb_add(&bar[XB_TOPGEN], 1u);
            else XB_SPIN(xb_ld(&bar[XB_TOPGEN]) == tg, bar);
            __builtin_amdgcn_fence(__ATOMIC_ACQUIRE, "agent");
            xb_add(&bar[XB_XGEN(b.x)], 1u);
            asm volatile("s_waitcnt vmcnt(0)" ::: "memory");
        } else {
            XB_SPIN(xb_ld(&bar[XB_XGEN(b.x)]) == gen, bar);
            __builtin_amdgcn_fence(__ATOMIC_ACQUIRE, "agent");
            asm volatile("s_waitcnt vmcnt(0)" ::: "memory");
        }
    }
    __syncthreads();
}
constexpr size_t MiB = 1u << 20;
constexpr size_t WS_CTL = 0, CTL_ZERO_BYTES = 1 * MiB, WS_SSQ_OFF = 512 * 1024;
constexpr size_t WS_WIN = 2 * MiB, WS_WOUT = 9 * MiB, WS_WUP = 11 * MiB, WS_WDN = 22 * MiB, WS_WLT = 28 * MiB;
constexpr size_t WS_XN = 32 * MiB, WS_QB = 66 * MiB, WS_KB = 83 * MiB, WS_VB = 100 * MiB, WS_MIX = 117 * MiB, WS_X1 = 151 * MiB;
constexpr size_t WS_PROJ = 218 * MiB, WS_Z = WS_PROJ, WS_LW = 436 * MiB, WS_LIN = 564 * MiB;
constexpr size_t WS_RW = 436 * MiB, RW_STRIDE = (size_t)cfg::M * 512 * 4, WS_ACT = WS_RW;
constexpr size_t WS_SC = 671 * MiB, SC_STRIDE = (size_t)cfg::M * 8 * 4;
constexpr size_t WS_VX = 600 * MiB;
constexpr size_t WS_YI = 673 * MiB, WS_QC = 707 * MiB, WS_PC = 740 * MiB, WS_GC = 773 * MiB, WS_S0 = 806 * MiB, WS_DPART = 839 * MiB, WS_DML = 871 * MiB, WS_END = 872 * MiB;
static_assert(WS_WIN + (size_t)3328 * 1024 * 2 <= WS_WOUT && WS_WUP + (size_t)5632 * 1024 * 2 <= WS_WDN && WS_WDN + (size_t)1024 * 2816 * 2 <= WS_WLT, "ws weights");
static_assert(WS_XN + (size_t)cfg::M * 1024 * 2 <= WS_QB && WS_QB + (size_t)cfg::M * 512 * 2 <= WS_KB && WS_VB + (size_t)cfg::M * 512 * 2 <= WS_MIX && WS_MIX + (size_t)cfg::M * 1024 * 2 <= WS_X1, "ws act");
static_assert(WS_X1 + (size_t)cfg::M * 1024 * 4 <= WS_PROJ && WS_PROJ + (size_t)cfg::M * 3328 * 4 <= WS_RW && WS_Z + (size_t)cfg::M * 5632 * 2 <= WS_RW, "ws proj");
static_assert(WS_LW + (size_t)cfg::M * 1536 * 2 <= WS_LIN && WS_LIN + (size_t)cfg::M * 256 * 2 <= WS_VX && WS_VX + RW_STRIDE <= WS_SC && WS_SC + 3 * SC_STRIDE <= WS_YI && WS_YI + RW_STRIDE <= WS_QC && WS_QC + (size_t)8 * 257 * 4096 * 4 <= WS_PC, "ws rw");
static_assert(WS_PC + (size_t)8 * 257 * 4096 * 4 <= WS_GC && WS_GC + (size_t)8 * 257 * 4096 * 4 <= WS_S0 && WS_S0 + (size_t)8 * 257 * 4096 * 4 <= WS_DPART && WS_DPART + (size_t)256 * 8 * 2 * 2048 * 4 <= WS_DML, "ws rw2");
constexpr int CW_BAR = 4096;
constexpr int CW_QATT = 64, CW_QDEC = 128;
constexpr int CW_QH = 2048;
constexpr int CW_R2DONE = 192, CW_DECDONE = 320;

constexpr int RING_OFF = 0, RING_BYTES = 131072;
constexpr int LDSCTL_OFF = RING_BYTES, MISC_OFF = LDSCTL_OFF + 320;
constexpr float ATT_THR = 6.0f;
constexpr int ATT_TB_OFF = MISC_OFF + 256;
constexpr int LDS_BYTES = 147456;
constexpr int NWAVES = 8;
constexpr int N_LAUNCHES = MK_N_LAUNCHES;
constexpr int N_PHASES = 13;

typedef float f32x16 __attribute__((ext_vector_type(16)));
typedef short s16x4 __attribute__((ext_vector_type(4)));
typedef short v4i16_t __attribute__((ext_vector_type(4)));

struct Args { const float* in[35]; float* out; unsigned char* ws; int ph_lo, ph_hi, li, pad; };
enum { I_XP = 0, I_XS, I_CK, I_CV, I_SRW, I_SSH, I_SCV, I_META, I_RELB, I_LN1, I_WIN, I_QNG, I_KNG, I_LQ1, I_LK1, I_LQ2, I_LK2, I_SUBLN, I_MU, I_W0, I_W2, I_A0, I_A2, I_G2,
       I_KK, I_KA, I_RK, I_LNXW, I_LNXB, I_WOUT, I_LN2, I_WUP, I_CONVW, I_CONVB, I_WDN };

__device__ __forceinline__ float wave_sum(float v) {
#pragma unroll
    for (int o = 1; o < 64; o <<= 1) v += __shfl_xor(v, o);
    return v;
}
__device__ __forceinline__ float quad_sum(float x) {
    x += __int_as_float(__builtin_amdgcn_mov_dpp(__float_as_int(x), 0xB1, 0xF, 0xF, true));
    x += __int_as_float(__builtin_amdgcn_mov_dpp(__float_as_int(x), 0x4E, 0xF, 0xF, true));
    return x;
}
__device__ __forceinline__ float sum16(float x) {
    x += __shfl_xor(x, 1); x += __shfl_xor(x, 2); x += __shfl_xor(x, 4); x += __shfl_xor(x, 8); return x;
}
__device__ __forceinline__ bf16x8 pack8(float a0, float a1, float a2, float a3, float a4, float a5, float a6, float a7) {
    v4u w; w.x = pk2(a0, a1); w.y = pk2(a2, a3); w.z = pk2(a4, a5); w.w = pk2(a6, a7); return __builtin_bit_cast(bf16x8, w);
}
__device__ __forceinline__ float ex2(float x) { return __builtin_amdgcn_exp2f(x); }
__device__ __forceinline__ float fexp(float x) { return __builtin_amdgcn_exp2f(x * 1.4426950408889634f); }
__device__ __forceinline__ float flog(float x) { return __builtin_amdgcn_logf(x) * 0.6931471805599453f; }
__device__ __forceinline__ float sigm(float x) { return __builtin_amdgcn_rcpf(1.0f + fexp(-x)); }
__device__ __forceinline__ float ftanh(float x) { return 1.0f - 2.0f * __builtin_amdgcn_rcpf(fexp(2.0f * x) + 1.0f); }
#define MFMA16(a, b, c) __builtin_amdgcn_mfma_f32_16x16x32_bf16((a), (b), (c), 0, 0, 0)
#define MFMA32(a, b, c) __builtin_amdgcn_mfma_f32_32x32x16_bf16((a), (b), (c), 0, 0, 0)
#define MFMA4F(a, b, c) __builtin_amdgcn_mfma_f32_16x16x4f32((a), (b), (c), 0, 0, 0)

__device__ __forceinline__ void p0_transpose_item(const float* W, int K, int N, bf16* WT, int row_off, LAS float* scr, int item, int lane, const float* kscale = nullptr) {
    const int nblk = N / 32, kb = item / nblk, nb = item % nblk, k0 = 64 * kb, n0 = 32 * nb;
#pragma unroll 8
    for (int i = 0; i < 32; ++i) { const int kk = 2 * i + (lane >> 5); float w = W[(size_t)(k0 + kk) * N + n0 + (lane & 31)]; if (kscale) w *= kscale[k0 + kk]; scr[kk * 33 + (lane & 31)] = w; }
    LDS_WAIT(); asm volatile("" ::: "memory");
    const int c = lane & 7;
#pragma unroll
    for (int j = 0; j < 4; ++j) { const int n = (lane >> 3) + 8 * j; const LAS float* s = scr + (8 * c) * 33 + n;
        v4u o; o.x = pk2(s[0 * 33], s[1 * 33]); o.y = pk2(s[2 * 33], s[3 * 33]); o.z = pk2(s[4 * 33], s[5 * 33]); o.w = pk2(s[6 * 33], s[7 * 33]);
        *(GAS v4u*)(WT + (size_t)(row_off + n0 + n) * K + k0 + 8 * c) = o; }
    LDS_WAIT(); asm volatile("" ::: "memory");
}
__device__ __forceinline__ void rms_row_bf16(const float* src, const float* gain, bf16* dst, int lane) {
    GAS unsigned long long* o8 = (GAS unsigned long long*)dst + lane;
    if (!src) {
#pragma unroll
        for (int j = 0; j < 4; ++j) o8[64 * j] = 0ull;
        return;
    }
    const GAS f32x4* xr = (const GAS f32x4*)src + lane; const GAS f32x4* gr = (const GAS f32x4*)gain + lane;
    f32x4 v[4]; float s = 0.f;
#pragma unroll
    for (int j = 0; j < 4; ++j) { v[j] = xr[64 * j]; s += (v[j].x * v[j].x + v[j].y * v[j].y) + (v[j].z * v[j].z + v[j].w * v[j].w); }
    const float rs = 1.0f / sqrtf(wave_sum(s) * (1.0f / 1024.0f) + cfg::NORM_EPS);
#pragma unroll
    for (int j = 0; j < 4; ++j) { const f32x4 g = gr[64 * j];
        o8[64 * j] = (unsigned long long)pk2(v[j].x * rs * g.x, v[j].y * rs * g.y) | ((unsigned long long)pk2(v[j].z * rs * g.z, v[j].w * rs * g.w) << 32); }
}
__device__ __forceinline__ void late_weights(const Args& a, LAS unsigned char* lds, int pw, int NPW, int wave, int lane) {
    LAS float* scr = (LAS float*)(lds + wave * 16384);
    unsigned char* ws = a.ws;
    constexpr int N_OUT = 16 * 32, N_UP = 16 * 176, N_DN = 44 * 32;
    for (int it = pw; it < N_OUT + N_UP + N_DN; it += NPW) {
        int r = it;
        if (r < N_OUT) { p0_transpose_item(a.in[I_WOUT], 1024, 1024, (bf16*)(ws + WS_WOUT), 0, scr, r, lane); continue; } r -= N_OUT;
        if (r < N_UP) { const int n0 = 32 * (r % 176), hf = n0 >= 2816, cc = n0 - hf * 2816;
            p0_transpose_item(a.in[I_WUP], 1024, 5632, (bf16*)(ws + WS_WUP), 256 * (cc >> 7) + 128 * hf + (cc & 127) - n0, scr, r, lane); continue; } r -= N_UP;
        p0_transpose_item(a.in[I_WDN], 2816, 1024, (bf16*)(ws + WS_WDN), 0, scr, r, lane);
    }
}
__device__ __forceinline__ void ph_prologue(const Args& a, LAS unsigned char* lds, int gw, int NGW, int wave, int lane) {
    using namespace cfg;
    LAS float* scr = (LAS float*)(lds + wave * 16384);
    unsigned char* ws = a.ws;
    constexpr int N_IN = 16 * 104;
    for (int it = gw; it < N_IN; it += NGW) p0_transpose_item(a.in[I_WIN], 1024, 3328, (bf16*)(ws + WS_WIN), 0, scr, it, lane);
    {
        bf16* WLT = (bf16*)(ws + WS_WLT);
        for (int it = gw * 64 + lane; it < 1536 * 32; it += NGW * 64) { const int n = it >> 5, k0 = (it & 31) * 8, sect = n >> 9, c = n & 511; float v[8];
#pragma unroll
            for (int i = 0; i < 8; ++i) { const int k = k0 + i; v[i] = sect == 0 ? (k < 64 ? a.in[I_W2][k * 512 + c] : 0.f) : sect == 1 ? ((k >= 64 && k < 128) ? a.in[I_A2][(k - 64) * 512 + c] : 0.f) : (k >= 128 ? a.in[I_G2][(k - 128) * 512 + c] : 0.f); }
            v4u w; w.x = pk2(v[0], v[1]); w.y = pk2(v[2], v[3]); w.z = pk2(v[4], v[5]); w.w = pk2(v[6], v[7]); *(v4u*)(WLT + (size_t)n * 256 + k0) = w; }
    }
    bf16* XN = (bf16*)(ws + WS_XN);
    for (int m = gw; m < M; m += NGW) rms_row_bf16(pg8::x_src_row(m, a.in[I_XP], a.in[I_XS], a.in[I_META]), a.in[I_LN1], XN + (size_t)m * DM, lane);
}

__device__ __forceinline__ void unpack8(v4u w, float* f) {
    f[0] = __uint_as_float(w.x << 16); f[1] = __uint_as_float(w.x & 0xffff0000u); f[2] = __uint_as_float(w.y << 16); f[3] = __uint_as_float(w.y & 0xffff0000u);
    f[4] = __uint_as_float(w.z << 16); f[5] = __uint_as_float(w.z & 0xffff0000u); f[6] = __uint_as_float(w.w << 16); f[7] = __uint_as_float(w.w & 0xffff0000u);
}
__device__ __forceinline__ void ph_rowpass(const Args& a, int gw, int NGW, int lane) {
    using namespace cfg;
    const bf16* PROJ = (const bf16*)(a.ws + WS_PROJ);
    bf16* Qb = (bf16*)(a.ws + WS_QB); bf16* Kb = (bf16*)(a.ws + WS_KB); bf16* Vb = (bf16*)(a.ws + WS_VB); bf16* LIN = (bf16*)(a.ws + WS_LIN);
    float qg[8], kg[8];
#pragma unroll
    for (int i = 0; i < 8; ++i) { qg[i] = a.in[I_QNG][8 * (lane & 7) + i] * QSCALE; kg[i] = a.in[I_KNG][8 * (lane & 7) + i]; }
    for (int m = gw; m < M; m += NGW) {
        const bf16* p = PROJ + (size_t)m * NPROJ + 8 * lane;
        const v4u qw = *(const v4u*)p, kw = *(const v4u*)(p + 512), vw = *(const v4u*)(p + 1024);
        float q[8], k[8], v[8]; unpack8(qw, q); unpack8(kw, k); unpack8(vw, v);
        float sq = 0.f, sk = 0.f;
#pragma unroll
        for (int i = 0; i < 8; ++i) { sq += q[i] * q[i]; sk += k[i] * k[i]; }
        sq += __shfl_xor(sq, 1); sq += __shfl_xor(sq, 2); sq += __shfl_xor(sq, 4);
        sk += __shfl_xor(sk, 1); sk += __shfl_xor(sk, 2); sk += __shfl_xor(sk, 4);
        const float rq = 1.0f / sqrtf(sq * (1.0f / 64.0f) + NORM_EPS), rk = 1.0f / sqrtf(sk * (1.0f / 64.0f) + NORM_EPS);
        v4u w;
        w.x = pk2(q[0] * rq * qg[0], q[1] * rq * qg[1]); w.y = pk2(q[2] * rq * qg[2], q[3] * rq * qg[3]); w.z = pk2(q[4] * rq * qg[4], q[5] * rq * qg[5]); w.w = pk2(q[6] * rq * qg[6], q[7] * rq * qg[7]);
        *(v4u*)(Qb + (size_t)m * 512 + 8 * lane) = w;
#pragma unroll
        for (int i = 0; i < 8; ++i) k[i] = k[i] * rk * kg[i];
        w.x = pk2(k[0], k[1]); w.y = pk2(k[2], k[3]); w.z = pk2(k[4], k[5]); w.w = pk2(k[6], k[7]);
        *(v4u*)(Kb + (size_t)m * 512 + 8 * lane) = w;
        *(v4u*)(Vb + (size_t)m * 512 + 8 * lane) = vw;
        float* kdst = nullptr; float* vdst = nullptr; float* sdst = nullptr;
        if (m >= FPAD && m < MP) { kdst = a.out + O_KP + (size_t)(m - FPAD) * 512; vdst = a.out + O_VP + (size_t)(m - FPAD) * 512; }
        else if (m >= MPP) { kdst = a.out + O_KS + (size_t)(m - MPP) * 512; vdst = a.out + O_VS + (size_t)(m - MPP) * 512; }
        if (kdst) { *(f32x4*)(kdst + 8 * lane) = (f32x4){k[0], k[1], k[2], k[3]}; *(f32x4*)(kdst + 8 * lane + 4) = (f32x4){k[4], k[5], k[6], k[7]};
                    *(f32x4*)(vdst + 8 * lane) = (f32x4){v[0], v[1], v[2], v[3]}; *(f32x4*)(vdst + 8 * lane + 4) = (f32x4){v[4], v[5], v[6], v[7]}; }
        if (m == MP - 1) sdst = a.out + O_HP; else if (m >= MPP && ((m - MPP) & 15) == 15) sdst = a.out + O_HS + (size_t)((m - MPP) >> 4) * NPR;
        if (sdst) { const bf16* pr = PROJ + (size_t)m * NPROJ + PR0; for (int c = lane; c < NPR; c += 64) sdst[c] = __uint_as_float((unsigned)pr[c] << 16); }
        if (lane < 32) {
            const int c = 8 * lane, sect = c >> 6;
            float x[8], pv[8]; unpack8(*(const v4u*)(PROJ + (size_t)m * NPROJ + PR0 + 1536 + c), x);
            const bool dec0 = m >= MPP && ((m - MPP) & 15) == 0;
            if (dec0) { const float* sh = a.in[I_SSH] + (size_t)((m - MPP) >> 4) * NPR + 1536 + c; const f32x4 s0 = *(const f32x4*)sh, s1 = *(const f32x4*)(sh + 4); pv[0] = s0.x; pv[1] = s0.y; pv[2] = s0.z; pv[3] = s0.w; pv[4] = s1.x; pv[5] = s1.y; pv[6] = s1.z; pv[7] = s1.w; }
            else if (m == 0) {
#pragma unroll
                for (int i = 0; i < 8; ++i) pv[i] = 0.f; }
            else unpack8(*(const v4u*)(PROJ + (size_t)(m - 1) * NPROJ + PR0 + 1536 + c), pv);
            const float* mu = a.in[I_MU] + 1536 + c;
#pragma unroll
            for (int i = 0; i < 8; ++i) { float xm = x[i] + (pv[i] - x[i]) * mu[i]; xm = sect == 0 ? ftanh(xm) : sect == 1 ? xm : sigm(xm); x[i] = xm; }
            w.x = pk2(x[0], x[1]); w.y = pk2(x[2], x[3]); w.z = pk2(x[4], x[5]); w.w = pk2(x[6], x[7]);
            *(v4u*)(LIN + (size_t)m * 256 + c) = w;
        }
    }
}

typedef float f32x2 __attribute__((ext_vector_type(2)));
__device__ __forceinline__ float fma_s(float a, float b, float c) { float d; asm("v_fma_f32 %0, %1, %2, %3" : "=v"(d) : "v"(a), "v"(b), "v"(c)); return d; }
__device__ __forceinline__ float fma_v(float a, float b, float c) { float d; asm volatile("v_fma_f32 %0, %1, %2, %3" : "=v"(d) : "v"(a), "v"(b), "v"(c)); return d; }
__device__ __forceinline__ float mul_s(float a, float b) { float d; asm("v_mul_f32_e32 %0, %1, %2" : "=v"(d) : "v"(a), "v"(b)); return d; }
__device__ __forceinline__ float row16_sum(float x) {
    x += __int_as_float(__builtin_amdgcn_mov_dpp(__float_as_int(x), 0xB1, 0xF, 0xF, true));
    x += __int_as_float(__builtin_amdgcn_mov_dpp(__float_as_int(x), 0x4E, 0xF, 0xF, true));
    x += __int_as_float(__builtin_amdgcn_mov_dpp(__float_as_int(x), 0x141, 0xF, 0xF, true));
    x += __int_as_float(__builtin_amdgcn_mov_dpp(__float_as_int(x), 0x140, 0xF, 0xF, true));
    return x;
}
__device__ __forceinline__ f32x4 unpack4(unsigned lo, unsigned hi) { return (f32x4){__uint_as_float(lo << 16), __uint_as_float(lo & 0xffff0000u), __uint_as_float(hi << 16), __uint_as_float(hi & 0xffff0000u)}; }
constexpr int R1_LWB = 2 * (49152 + 512) + 8192, R1_CAR = R1_LWB + 8192;
constexpr int R1_BUF = 49152 + 512, R1_CST = 2 * R1_BUF;
struct R1Unit { int kind, h, cb, row0, nsub; };
__device__ __forceinline__ void r1_run(const Args& a, LAS unsigned char* lds, const R1Unit u, int tid, int wave, int lane) {
    using namespace cfg;
    asm volatile("" : "+v"(lane), "+v"(tid));
    const bf16* PROJ = (const bf16*)(a.ws + WS_PROJ); const bf16* LW = (const bf16*)(a.ws + WS_LW);
    float* YI = (float*)(a.ws + WS_YI); float* QC = (float*)(a.ws + WS_QC); float* PC = (float*)(a.ws + WS_PC); float* GC = (float*)(a.ws + WS_GC); float* RKR = (float*)(a.ws + WS_SC); float* VX = (float*)(a.ws + WS_VX);
    const int p = wave >> 1, role = wave & 1, q = lane & 3, rg = lane >> 2;
    const int ss = (tid >> 4) & 7, ch4 = (tid & 15) * 4, cc = u.h * 64 + ch4;
    { LAS float* cst = (LAS float*)(lds + R1_CST) + p * 512; const int x = tid & 127;
#pragma unroll
      for (int i = 0; i < 4; ++i) { const int e = x + 128 * i, arr = e >> 6, ch = e & 63; const int gc = u.h * 64 + ch;
          const float v = arr == 0 ? a.in[I_MU][gc] : arr == 1 ? a.in[I_MU][512 + gc] : arr == 2 ? a.in[I_MU][1024 + gc] : arr == 3 ? a.in[I_W0][gc] : arr == 4 ? a.in[I_A0][gc] : arr == 5 ? a.in[I_KK][gc] : arr == 6 ? a.in[I_KA][gc] : a.in[I_RK][gc];
          cst[e] = v; }
      if (x < 64) ((LAS float*)(lds + R1_CAR))[p * 64 + x] = 0.f; }
    f32x2 S[4][8];
#pragma unroll
    for (int ii = 0; ii < 2; ++ii) {
        if (u.kind == 2) { const float* sp = a.in[I_SRW] + ((size_t)(u.cb * 8 + u.h) * 64 + rg + 16 * ii + 32 * role) * 64 + 16 * q;
#pragma unroll
            for (int j4 = 0; j4 < 4; ++j4) { const f32x4 v = *(const f32x4*)(sp + 4 * j4); S[ii][2 * j4] = (f32x2){v.x, v.y}; S[ii][2 * j4 + 1] = (f32x2){v.z, v.w}; } }
        else {
#pragma unroll
            for (int j2 = 0; j2 < 8; ++j2) S[ii][j2] = (f32x2){0.f, 0.f}; }
    }
    { int rgv = rg; asm volatile("" : "+v"(rgv));
#pragma unroll
      for (int ii = 2; ii < 4; ++ii)
#pragma unroll
          for (int j2 = 0; j2 < 8; ++j2) S[ii][j2] = (f32x2){(q == ii - 2 + 2 * role && rgv == 2 * j2) ? 1.0f : 0.0f, (q == ii - 2 + 2 * role && rgv == 2 * j2 + 1) ? 1.0f : 0.0f}; }
    const bool ystore = !(u.kind == 2 && q >= 2);
    float* yout = q < 2 ? YI + (size_t)u.row0 * 512 + u.h * 64 + rg + 16 * q + 32 * role : GC + (size_t)(u.h * NCH + u.cb) * 4096 + (size_t)(u.row0 & 63) * 64 + rg + 16 * (q - 2) + 32 * role;
    const int ystride = q < 2 ? 512 : 64;
    unsigned sr[8][2];
#define R1_LOAD(sc) do { const unsigned row_ = (unsigned)(u.row0 + 8 * (sc) + ss); const bf16* pp_ = PROJ + (size_t)row_ * NPROJ + PR0 + cc; \
        _Pragma("unroll") for (int x_ = 0; x_ < 3; ++x_) { const unsigned long long c_ = *(const unsigned long long*)(pp_ + 512 * x_), d_ = *(const unsigned long long*)(pp_ - NPROJ + 512 * x_); \
            sr[x_][0] = (unsigned)c_; sr[x_][1] = (unsigned)(c_ >> 32); sr[3 + x_][0] = (unsigned)d_; sr[3 + x_][1] = (unsigned)(d_ >> 32); } \
        { const unsigned long long c_ = *(const unsigned long long*)(LW + (size_t)row_ * 1536 + cc), d_ = *(const unsigned long long*)(LW + (size_t)row_ * 1536 + 512 + cc); sr[6][0] = (unsigned)c_; sr[6][1] = (unsigned)(c_ >> 32); sr[7][0] = (unsigned)d_; sr[7][1] = (unsigned)(d_ >> 32); } } while (0)
#define R1_STAGE(sc, buf) do { const unsigned row_ = (unsigned)(u.row0 + 8 * (sc) + ss); \
        const LAS float* cs_ = (const LAS float*)(lds + R1_CST) + p * 512 + ch4; \
        f32x4 xr_ = unpack4(sr[0][0], sr[0][1]), xk_ = unpack4(sr[1][0], sr[1][1]), xv_ = unpack4(sr[2][0], sr[2][1]); \
        f32x4 pr_ = unpack4(sr[3][0], sr[3][1]), pk_ = unpack4(sr[4][0], sr[4][1]), pv_ = unpack4(sr[5][0], sr[5][1]); \
        if (u.kind == 2 && (sc) == 0 && ss == 0) { const float* sh_ = a.in[I_SSH] + (size_t)u.cb * NPR + cc; pr_ = *(const f32x4*)sh_; pk_ = *(const f32x4*)(sh_ + 512); pv_ = *(const f32x4*)(sh_ + 1024); } \
        const f32x4 r_ = xr_ + (pr_ - xr_) * *(const LAS f32x4*)(cs_), k_ = xk_ + (pk_ - xk_) * *(const LAS f32x4*)(cs_ + 64), v_ = xv_ + (pv_ - xv_) * *(const LAS f32x4*)(cs_ + 128); \
        __builtin_amdgcn_sched_barrier(0); \
        const f32x4 w0_ = *(const LAS f32x4*)(cs_ + 192), a0_ = *(const LAS f32x4*)(cs_ + 256), kkc_ = *(const LAS f32x4*)(cs_ + 320), kac_ = *(const LAS f32x4*)(cs_ + 384), rkc_ = *(const LAS f32x4*)(cs_ + 448); \
        const f32x4 slw0_ = unpack4(sr[6][0], sr[6][1]), slw1_ = unpack4(sr[7][0], sr[7][1]); f32x4 al_, dec_, kkr_ = k_ * kkc_; \
        _Pragma("unroll") for (int e_ = 0; e_ < 4; ++e_) { al_[e_] = sigm(a0_[e_] + slw1_[e_]); const float xw_ = w0_[e_] + slw0_[e_]; \
            const float sp_ = fmaxf(-xw_, 0.f) + flog(1.0f + fexp(-fabsf(xw_))); dec_[e_] = -fexp(-sp_ - 0.5f); }        \
        __builtin_amdgcn_sched_barrier(0); \
          \
        { LAS float* lwb_ = (LAS float*)(lds + R1_LWB) + (p * 8 + ss) * 64 + ch4; *(LAS f32x4*)lwb_ = dec_; } \
        __syncthreads(); \
        f32x4 Lt_ = *(const LAS f32x4*)((const LAS float*)(lds + R1_CAR) + (((sc) & 1) * 4 + p) * 64 + ch4); \
        _Pragma("unroll") for (int s_ = 0; s_ < 8; ++s_) { const f32x4 x_ = *(const LAS f32x4*)((const LAS float*)(lds + R1_LWB) + (p * 8 + s_) * 64 + ch4); if (s_ <= ss) Lt_ += x_; } \
        if (ss == 7) *(LAS f32x4*)((LAS float*)(lds + R1_CAR) + ((((sc) + 1) & 1) * 4 + p) * 64 + ch4) = Lt_; \
        __builtin_amdgcn_sched_barrier(0); \
        f32x4 ea_, eb_, er_; \
        _Pragma("unroll") for (int e_ = 0; e_ < 4; ++e_) { ea_[e_] = fexp(Lt_[e_] - dec_[e_]); eb_[e_] = fexp(-Lt_[e_]); er_[e_] = fexp(Lt_[e_]); } \
        __builtin_amdgcn_sched_barrier(0); \
        const float inv_ = 1.0f / fmaxf(sqrtf(row16_sum((kkr_.x * kkr_.x + kkr_.y * kkr_.y) + (kkr_.z * kkr_.z + kkr_.w * kkr_.w))), 1e-12f); \
        const f32x4 kk_ = kkr_ * inv_, kp_ = k_ * (1.0f + (al_ - 1.0f) * kac_), bb_ = kk_ * al_; \
        const f32x4 t1_ = bb_ * r_, t2_ = kp_ * r_, t3_ = t2_ * rkc_; \
        const float br_ = row16_sum((t1_.x + t1_.y) + (t1_.z + t1_.w)), kr_ = row16_sum((t2_.x + t2_.y) + (t2_.z + t2_.w)), rkr_ = row16_sum((t3_.x + t3_.y) + (t3_.z + t3_.w)); \
        LAS float* vb_ = (LAS float*)(lds + (buf) * R1_BUF + (p * 8 + ss) * 1536) + ch4; \
          \
        *(LAS f32x4*)(vb_) = -kk_ * ea_; *(LAS f32x4*)(vb_ + 128) = r_ * er_; *(LAS f32x4*)(vb_ + 192) = bb_ * eb_; *(LAS f32x4*)(vb_ + 256) = kp_ * eb_; *(LAS f32x4*)(vb_ + 320) = v_; \
        *(f32x4*)(VX + (size_t)row_ * 512 + cc) = v_; \
        if ((tid & 15) == 0) { LAS float* sc_ = (LAS float*)(lds + (buf) * R1_BUF + 49152) + (p * 8 + ss) * 2; sc_[0] = br_; sc_[1] = kr_; RKR[(size_t)row_ * 8 + u.h] = rkr_; } } while (0)
    R1_LOAD(0);
    __syncthreads();
    R1_STAGE(0, 0);
    __syncthreads();
    for (int sc = 0; sc < u.nsub; ++sc) {
        const bool more = sc + 1 < u.nsub;
        if (more) R1_LOAD(sc + 1);
        {
            const LAS unsigned char* bb = lds + (sc & 1) * R1_BUF;
#define R1_STEP(VAL) do { \
                const LAS float* vb = (const LAS float*)(bb + (p * 8 + s) * 1536) + 16 * q; \
                f32x4 xb[4], xk[4];                                      \
                _Pragma("unroll") for (int j4 = 0; j4 < 4; ++j4) { xb[j4] = *(const LAS f32x4*)(vb + 192 + 4 * j4); if (VAL) xk[j4] = *(const LAS f32x4*)(vb + 256 + 4 * j4); } \
                float vv[4] = {0.f, 0.f, 0.f, 0.f}; \
                _Pragma("unroll") for (int ii = 0; ii < 2; ++ii) vv[ii] = ((const LAS float*)(bb + (p * 8 + s) * 1536))[320 + rg + 16 * ii + 32 * role]; \
                const LAS float* scl = (const LAS float*)(bb + 49152) + (p * 8 + s) * 2; \
                const float brs = scl[0], krs = scl[1]; \
                float ys[4], d1a[4], d1b[4], d2a[4], d2b[4], dd1[4];     \
                _Pragma("unroll") for (int ii = 0; ii < 4; ++ii) { d1a[ii] = 0.f; d1b[ii] = 0.f; d2a[ii] = 0.f; d2b[ii] = 0.f; }     \
                _Pragma("unroll") for (int hf = 0; hf < 2; ++hf) if (hf == 0 || idn) {     \
                _Pragma("unroll") for (int j2 = 0; j2 < 8; ++j2) \
                    _Pragma("unroll") for (int ii = 2 * hf; ii < 2 * hf + 2; ++ii) { const float sx = S[ii][j2].x, sy = S[ii][j2].y; \
                        d1a[ii] = fma_v(sx, xa[j2 >> 1][2 * (j2 & 1)], d1a[ii]); d1b[ii] = fma_v(sy, xa[j2 >> 1][2 * (j2 & 1) + 1], d1b[ii]); \
                        d2a[ii] = fma_v(sx, xwr[j2 >> 1][2 * (j2 & 1)], d2a[ii]); d2b[ii] = fma_v(sy, xwr[j2 >> 1][2 * (j2 & 1) + 1], d2b[ii]); } } \
                asm volatile("" ::: "memory");                           \
                if (s < 7) { const LAS float* vn = vb + 384;               \
                    _Pragma("unroll") for (int j4 = 0; j4 < 4; ++j4) { xa[j4] = *(const LAS f32x4*)(vn + 4 * j4); xwr[j4] = *(const LAS f32x4*)(vn + 128 + 4 * j4); } } \
                _Pragma("unroll") for (int ii = 0; ii < 4; ++ii) { \
                    const float d1 = quad_sum(d1a[ii] + d1b[ii]), d2 = quad_sum(d2a[ii] + d2b[ii]); dd1[ii] = d1; \
                    ys[ii] = ii < 2 ? d2 + d1 * brs + vv[ii] * krs : d2 + d1 * brs; } \
                _Pragma("unroll") for (int jp = 0; jp < 8; jp += 2) { float sx[2][2], sy[2][2];     \
                    _Pragma("unroll") for (int jj = 0; jj < 2; ++jj) _Pragma("unroll") for (int ii = 0; ii < 2; ++ii) { const int j2 = jp + jj; sx[jj][ii] = fma_v(xb[j2 >> 1][2 * (j2 & 1)], dd1[ii], S[ii][j2].x); sy[jj][ii] = fma_v(xb[j2 >> 1][2 * (j2 & 1) + 1], dd1[ii], S[ii][j2].y); } \
                    _Pragma("unroll") for (int jj = 0; jj < 2; ++jj) _Pragma("unroll") for (int ii = 0; ii < 2; ++ii) { const int j2 = jp + jj; sx[jj][ii] = fma_v(xk[j2 >> 1][2 * (j2 & 1)], vv[ii], sx[jj][ii]); sy[jj][ii] = fma_v(xk[j2 >> 1][2 * (j2 & 1) + 1], vv[ii], sy[jj][ii]); } \
                    _Pragma("unroll") for (int jj = 0; jj < 2; ++jj) _Pragma("unroll") for (int ii = 0; ii < 2; ++ii) S[ii][jp + jj] = (f32x2){sx[jj][ii], sy[jj][ii]}; } \
                if (idn) { _Pragma("unroll") for (int j2 = 0; j2 < 8; ++j2) _Pragma("unroll") for (int ii = 2; ii < 4; ++ii) {     \
                    const float sx = fma_v(xb[j2 >> 1][2 * (j2 & 1)], dd1[ii], S[ii][j2].x), sy = fma_v(xb[j2 >> 1][2 * (j2 & 1) + 1], dd1[ii], S[ii][j2].y); S[ii][j2] = (f32x2){sx, sy}; } } \
                const float ysel = q == 0 ? ys[0] : q == 1 ? ys[1] : q == 2 ? ys[2] : ys[3]; \
                if (ystore) yout[(size_t)(8 * sc + s) * ystride] = ysel; } while (0)
            const bool idn = u.kind != 2;
            f32x4 xa[4], xwr[4];
            { const LAS float* v0 = (const LAS float*)(bb + (p * 8) * 1536) + 16 * q;
#pragma unroll
              for (int j4 = 0; j4 < 4; ++j4) { xa[j4] = *(const LAS f32x4*)(v0 + 4 * j4); xwr[j4] = *(const LAS f32x4*)(v0 + 128 + 4 * j4); } }
#pragma unroll 1
            for (int s = 0; s < 8; ++s) R1_STEP(true);
#undef R1_STEP
        }
        if (more) R1_STAGE(sc + 1, (sc + 1) & 1);
        __syncthreads();
    }
#undef R1_LOAD
#undef R1_STAGE
    {
        { const LAS float* car = (const LAS float*)(lds + R1_CAR) + ((u.nsub & 1) * 4 + p) * 64 + 16 * q;
#pragma unroll
          for (int j4 = 0; j4 < 4; ++j4) { const f32x4 L4 = *(const LAS f32x4*)(car + 4 * j4); const float g0 = fexp(L4.x), g1 = fexp(L4.y), g2 = fexp(L4.z), g3 = fexp(L4.w);
#pragma unroll
              for (int ii = 0; ii < 4; ++ii) { S[ii][2 * j4].x *= g0; S[ii][2 * j4].y *= g1; S[ii][2 * j4 + 1].x *= g2; S[ii][2 * j4 + 1].y *= g3; } } }
        float* qout = u.kind == 2 ? a.out + O_SS + (size_t)(u.cb * 8 + u.h) * 4096 : QC + (size_t)(u.h * NCH + u.cb) * 4096;
        float* pout = PC + (size_t)(u.h * NCH + u.cb) * 4096;
#pragma unroll
        for (int ii = 0; ii < 4; ++ii) {
            if (ii >= 2 && u.kind == 2) continue;
            float* sp = (ii < 2 ? qout : pout) + (size_t)(rg + 16 * (ii & 1) + 32 * role) * 64 + 16 * q;
#pragma unroll
            for (int j4 = 0; j4 < 4; ++j4) *(f32x4*)(sp + 4 * j4) = (f32x4){S[ii][2 * j4].x, S[ii][2 * j4].y, S[ii][2 * j4 + 1].x, S[ii][2 * j4 + 1].y};
        }
    }
}
__device__ __forceinline__ void ph_r1(const Args& a, LAS unsigned char* lds, int bx, int G, int tid, int wave, int lane) {
    using namespace cfg;
    const int p = wave >> 1;
    for (int quad = bx; quad < 512 + 66; quad += G) {
        R1Unit u;
        if (quad < 512) { const int U = quad * 4 + p; u.kind = 0; u.h = U & 7; u.cb = 1 + (U >> 3); u.row0 = 64 * u.cb; u.nsub = 8; }
        else { const int su = (quad - 512) * 4 + p; u.nsub = 2;
            if (su < 8) { u.kind = 1; u.h = su; u.cb = 0; u.row0 = FPAD; } else { const int d = su - 8; u.kind = 2; u.h = d & 7; u.cb = d >> 3; u.row0 = MPP + 16 * u.cb; } }
        r1_run(a, lds, u, tid, wave, lane);
    }
}

__device__ __forceinline__ void ph_r2(const Args& a, LAS unsigned char* lds, int unit, int wave, int lane, gu32* done_cnt) {
    using namespace cfg;
    const float* QC = (const float*)(a.ws + WS_QC); const float* PC = (const float*)(a.ws + WS_PC); float* S0T = (float*)(a.ws + WS_S0);
    const int h = unit >> 2, rb = unit & 3, n = lane & 15, g = lane >> 4, i = 16 * rb + n;
    LAS float* st = (LAS float*)lds;
    for (int x = threadIdx.x; x < 2048; x += 512) st[x] = 0.f;
    __syncthreads();
    f32x4 mine = (f32x4){0.f, 0.f, 0.f, 0.f};
    float pa[16]; f32x4 q4 = (f32x4){0.f, 0.f, 0.f, 0.f};
    if (wave < 4) {
        const float* pc = PC + (size_t)(h * NCH) * 4096 + 16 * wave + n;
#pragma unroll
        for (int kk = 0; kk < 16; ++kk) pa[kk] = pc[(16 * (kk >> 2) + 4 * g + (kk & 3)) * 64];
        q4 = *(const f32x4*)(QC + (size_t)(h * NCH) * 4096 + (size_t)i * 64 + 16 * wave + 4 * g);
    }
    for (int c = 0; c < NCH; ++c) {
        const int cur = c & 1;
        if (wave < 4) {
            float* s0 = S0T + (size_t)(h * NCH + c) * 4096 + (size_t)(16 * wave + 4 * g) * 64 + i;
#pragma unroll
            for (int reg = 0; reg < 4; ++reg) s0[reg * 64] = mine[reg];
            float pn[16]; f32x4 qn = (f32x4){0.f, 0.f, 0.f, 0.f};
            if (c + 1 < NCH) {
                const float* pc = PC + (size_t)(h * NCH + c + 1) * 4096 + 16 * wave + n;
#pragma unroll
                for (int kk = 0; kk < 16; ++kk) pn[kk] = pc[(16 * (kk >> 2) + 4 * g + (kk & 3)) * 64];
                qn = *(const f32x4*)(QC + (size_t)(h * NCH + c + 1) * 4096 + (size_t)i * 64 + 16 * wave + 4 * g);
            } else {
#pragma unroll
                for (int kk = 0; kk < 16; ++kk) pn[kk] = 0.f;
            }
            float bvv[16];
#pragma unroll
            for (int kk = 0; kk < 16; ++kk) bvv[kk] = st[cur * 1024 + (16 * (kk >> 2) + 4 * g + (kk & 3)) * 16 + n];
            f32x4 acc0 = q4, acc1 = (f32x4){0.f, 0.f, 0.f, 0.f};
#pragma unroll
            for (int kk = 0; kk < 16; kk += 2) { acc0 = MFMA4F(pa[kk], bvv[kk], acc0); acc1 = MFMA4F(pa[kk + 1], bvv[kk + 1], acc1); }
            mine = acc0 + acc1;
#pragma unroll
            for (int reg = 0; reg < 4; ++reg) st[(cur ^ 1) * 1024 + (16 * wave + 4 * g + reg) * 16 + n] = mine[reg];
#pragma unroll
            for (int kk = 0; kk < 16; ++kk) pa[kk] = pn[kk];
            q4 = qn;
        }
        __syncthreads();
    }
    if (wave < 4) *(f32x4*)(a.out + O_SP + (size_t)(h * 64 + i) * 64 + 16 * wave + 4 * g) = mine;
    asm volatile("s_waitcnt vmcnt(0)" ::: "memory"); __syncthreads();
    if (threadIdx.x == 0) { __builtin_amdgcn_fence(__ATOMIC_RELEASE, "agent"); asm volatile("s_waitcnt vmcnt(0)" ::: "memory"); (void)__hip_atomic_fetch_add(done_cnt, 1u, __ATOMIC_RELAXED, __HIP_MEMORY_SCOPE_AGENT); }
}

__device__ __forceinline__ void glds16(const void* gsrc, unsigned lds_dst) {
    unsigned keep;
    asm volatile("s_mov_b32 %0, m0\n\ts_mov_b32 m0, %2\n\ts_nop 0\n\tglobal_load_lds_dwordx4 %1, off\n\ts_mov_b32 m0, %0" : "=&s"(keep) : "v"(gsrc), "s"(lds_dst) : "memory");
}
__device__ __forceinline__ void glds16s(const void* sbase, unsigned voff, unsigned lds_dst) {
    unsigned keep;
    asm volatile("s_mov_b32 %0, m0\n\ts_mov_b32 m0, %3\n\ts_nop 0\n\tglobal_load_lds_dwordx4 %1, %2\n\ts_mov_b32 m0, %0" : "=&s"(keep) : "v"(voff), "s"(sbase), "s"(lds_dst) : "memory");
}
__device__ __forceinline__ void dec_attn_unit(const Args& a, LAS unsigned char* lds, const LAS float* tb, int unit, int wave, int lane) {
    using namespace cfg;
    asm volatile("" : "+v"(lane));
    const int b = unit >> 3, h = (unit >> 1) & 3, half = unit & 1, n = lane & 15, g = lane >> 4;
    const bf16* Qb = (const bf16*)(a.ws + WS_QB);
    bf16x8 qf[2][2];
#pragma unroll
    for (int c = 0; c < 2; ++c)
#pragma unroll
        for (int ks = 0; ks < 2; ++ks) qf[c][ks] = *(const bf16x8*)(Qb + (size_t)(MPP + b * 16 + n) * 512 + h * 128 + c * 64 + 32 * ks + 8 * g);
    float mr[2] = {-1e30f, -1e30f}, lr[2] = {0.f, 0.f};
    f32x4 o[2][8];
#pragma unroll
    for (int c = 0; c < 2; ++c)
#pragma unroll
        for (int et = 0; et < 8; ++et) o[c][et] = (f32x4){0.f, 0.f, 0.f, 0.f};
    const int send = half ? 129 : 64;
    f32x4 kx[2][2][2][2];
#define DEC_KLOAD(s_) do { _Pragma("unroll") for (int kt2 = 0; kt2 < 2; ++kt2) { const int kt16 = 2 * (s_) + kt2; \
        const float* kp = (kt16 < 257 ? a.in[I_CK] + ((size_t)b * NCK + 16 * kt16 + n) * 512 : a.out + O_KS + ((size_t)b * 16 + n) * 512) + h * 128 + 8 * g; \
        _Pragma("unroll") for (int c = 0; c < 2; ++c) _Pragma("unroll") for (int ks = 0; ks < 2; ++ks) { kx[kt2][c][ks][0] = *(const f32x4*)(kp + c * 64 + 32 * ks); kx[kt2][c][ks][1] = *(const f32x4*)(kp + c * 64 + 32 * ks + 4); } } } while (0)
    LAS unsigned char* vb = lds + wave * 16384; const unsigned vb0 = (unsigned)(uintptr_t)vb;
    const unsigned voA = (unsigned)((lane >> 5) * 2048 + 16 * (lane & 31)), voB = (unsigned)((lane >> 5) * 2048 + 16 * ((lane & 31) ^ 4));
#define DEC_VDMA(s_) do { const char* cb_ = (const char*)(a.in[I_CV] + ((size_t)b * NCK + 32 * (s_)) * 512 + h * 128);     \
        const char* ob_ = (s_) == 128 ? (const char*)(a.out + O_VS + (size_t)b * 16 * 512 + h * 128) - 8 * 4096 : cb_;     \
        _Pragma("unroll") for (int i_ = 0; i_ < 16; ++i_) { const char* vp_ = (i_ >= 8 ? ob_ : cb_) + i_ * 4096; \
        unsigned keep_; asm volatile("s_mov_b32 %0, m0\n\ts_mov_b32 m0, %3\n\ts_nop 0\n\tglobal_load_lds_dwordx4 %1, %2\n\ts_mov_b32 m0, %0" : "=&s"(keep_) : "v"(((i_ >> 1) & 1) ? voB : voA), "s"(vp_), "s"((unsigned)__builtin_amdgcn_readfirstlane(vb0 + i_ * 1024)) : "memory"); } } while (0)
    if (64 * half + wave < send) { DEC_KLOAD(64 * half + wave); DEC_VDMA(64 * half + wave); }
    for (int s = 64 * half + wave; s < send; s += 8) {
        f32x4 sa[2][2];
#pragma unroll
        for (int kt2 = 0; kt2 < 2; ++kt2)
#pragma unroll
            for (int c = 0; c < 2; ++c) {
                f32x4 acc = (f32x4){0.f, 0.f, 0.f, 0.f};
#pragma unroll
                for (int ks = 0; ks < 2; ++ks) { const f32x4 x0 = kx[kt2][c][ks][0], x1 = kx[kt2][c][ks][1];
                    acc = MFMA16(pack8(x0.x, x0.y, x0.z, x0.w, x1.x, x1.y, x1.z, x1.w), qf[c][ks], acc); }
                sa[c][kt2] = acc;
            }
        if (s >= 120) {
#pragma unroll
            for (int kt2 = 0; kt2 < 2; ++kt2)
#pragma unroll
                for (int reg = 0; reg < 4; ++reg) { int idx = 16 * (2 * s + kt2) + 4 * g + reg - (NCK + n) + 191; idx = idx < 0 ? 0 : idx; const float bias = tb[idx];
                    sa[0][kt2][reg] += bias; sa[1][kt2][reg] += bias; }
        }
        bf16x8 pa[2];
#pragma unroll
        for (int c = 0; c < 2; ++c) {
            float mx = fmaxf(fmaxf(fmaxf(sa[c][0][0], sa[c][0][1]), fmaxf(sa[c][0][2], sa[c][0][3])), fmaxf(fmaxf(sa[c][1][0], sa[c][1][1]), fmaxf(sa[c][1][2], sa[c][1][3])));
            mx = fmaxf(mx, __shfl_xor(mx, 16)); mx = fmaxf(mx, __shfl_xor(mx, 32));
            const float mn = fmaxf(mr[c], mx), al = ex2(mr[c] - mn); mr[c] = mn;
            float p[8], ls = 0.f;
#pragma unroll
            for (int e = 0; e < 8; ++e) { p[e] = ex2(sa[c][e >> 2][e & 3] - mn); ls += p[e]; }
            lr[c] = lr[c] * al + ls;
            float alq[4];
#pragma unroll
            for (int reg = 0; reg < 4; ++reg) alq[reg] = __shfl(al, 4 * g + reg);
#pragma unroll
            for (int et = 0; et < 8; ++et) { o[c][et][0] *= alq[0]; o[c][et][1] *= alq[1]; o[c][et][2] *= alq[2]; o[c][et][3] *= alq[3]; }
            pa[c] = pack8(p[0], p[1], p[2], p[3], p[4], p[5], p[6], p[7]);
        }
        asm volatile("s_waitcnt vmcnt(0)" ::: "memory");
        { const LAS unsigned char* vl = vb + (4 * g) * 512 + (n >> 2) * 16 + (n & 3) * 4;
#pragma unroll
          for (int et = 0; et < 8; ++et) { const LAS unsigned char* ve = vl + 64 * (et ^ (g & 1)); float x[8];
#pragma unroll
              for (int j = 0; j < 8; ++j) x[j] = *(const LAS float*)(ve + (16 * (j >> 2) + (j & 3)) * 512);
              const bf16x8 vf = pack8(x[0], x[1], x[2], x[3], x[4], x[5], x[6], x[7]);
              o[0][et] = MFMA16(pa[0], vf, o[0][et]); o[1][et] = MFMA16(pa[1], vf, o[1][et]); } }
        if (s + 8 < send) { asm volatile("s_waitcnt lgkmcnt(0)" ::: "memory"); DEC_VDMA(s + 8); DEC_KLOAD(s + 8); }
    }
    asm volatile("s_waitcnt vmcnt(0)" ::: "memory");
#undef DEC_KLOAD
#undef DEC_VDMA
    float* part = (float*)(a.ws + WS_DPART) + (size_t)(unit * 8 + wave) * 2 * 2048; float* ml = (float*)(a.ws + WS_DML) + (size_t)(unit * 8 + wave) * 2 * 32;
#pragma unroll
    for (int c = 0; c < 2; ++c) {
        float l = lr[c]; l += __shfl_xor(l, 16); l += __shfl_xor(l, 32);
        if (g == 0) { ml[c * 32 + 2 * n] = mr[c]; ml[c * 32 + 2 * n + 1] = l; }
#pragma unroll
        for (int et = 0; et < 8; ++et)
#pragma unroll
            for (int reg = 0; reg < 4; ++reg) part[c * 2048 + (4 * g + reg) * 128 + 16 * et + n] = o[c][et][reg];
    }
}
__device__ __forceinline__ void build_bias_table(LAS float* tb, const float* relb, int h, int tid) {
    if (tid < 256) {
        const int rel = tid - 191, nn = rel < 0 ? -rel : rel;
        int bk = nn < 8 ? nn : nn < 12 ? 8 : nn < 16 ? 9 : nn < 23 ? 10 : nn < 32 ? 11 : nn < 46 ? 12 : nn < 64 ? 13 : nn < 91 ? 14 : 15;
        if (rel > 0) bk += 16;
        tb[tid] = (relb[bk * 4 + h] - relb[15 * 4 + h]) * 1.4426950408889634f;
    }
}
__device__ __forceinline__ void r3_unit(const Args& a, int tl, int h, int lane) {
    using namespace cfg;
    asm volatile("" : "+v"(lane));
    const float* GC = (const float*)(a.ws + WS_GC); const float* S0T = (const float*)(a.ws + WS_S0); const float* YI = (const float*)(a.ws + WS_YI);
    const float* VX = (const float*)(a.ws + WS_VX); const bf16* LW = (const bf16*)(a.ws + WS_LW); const float* RKR = (const float*)(a.ws + WS_SC);
    bf16* MIX = (bf16*)(a.ws + WS_MIX);
    const int n = lane & 15, g = lane >> 4;
    const int row0 = tl < NCH ? 64 * tl : MPP + 64 * (tl - NCH);
        f32x4 acc[4][4];
#pragma unroll
        for (int mt = 0; mt < 4; ++mt)
#pragma unroll
            for (int nt = 0; nt < 4; ++nt) acc[mt][nt] = (f32x4){0.f, 0.f, 0.f, 0.f};
        if (tl > 0 && tl < NCH) {
            const float* gp = GC + (size_t)(h * NCH + tl) * 4096 + n * 64 + 8 * g;
            const float* sp = S0T + (size_t)(h * NCH + tl) * 4096 + (8 * g) * 64 + n;
            bf16x8 af[2][4], bfr[2][4];
#pragma unroll
            for (int ks = 0; ks < 2; ++ks) {
#pragma unroll
                for (int mt = 0; mt < 4; ++mt) { const f32x4 x0 = *(const f32x4*)(gp + (size_t)mt * 1024 + 32 * ks), x1 = *(const f32x4*)(gp + (size_t)mt * 1024 + 32 * ks + 4); af[ks][mt] = pack8(x0.x, x0.y, x0.z, x0.w, x1.x, x1.y, x1.z, x1.w); }
#pragma unroll
                for (int nt = 0; nt < 4; ++nt) { float b8[8];
#pragma unroll
                    for (int e = 0; e < 8; ++e) b8[e] = sp[(size_t)(32 * ks + e) * 64 + 16 * nt];
                    bfr[ks][nt] = pack8(b8[0], b8[1], b8[2], b8[3], b8[4], b8[5], b8[6], b8[7]); } }
#pragma unroll
            for (int ks = 0; ks < 2; ++ks)
#pragma unroll
                for (int mt = 0; mt < 4; ++mt)
#pragma unroll
                    for (int nt = 0; nt < 4; ++nt) acc[mt][nt] = MFMA16(af[ks][mt], bfr[ks][nt], acc[mt][nt]);
        }
        float lw[4], lb[4];
#pragma unroll
        for (int nt = 0; nt < 4; ++nt) { lw[nt] = a.in[I_LNXW][h * 64 + 16 * nt + n]; lb[nt] = a.in[I_LNXB][h * 64 + 16 * nt + n]; }
#pragma unroll
        for (int mt = 0; mt < 4; ++mt) {
            float yi[4][4], vx[4][4], gg[4][4], rk[4];
#pragma unroll
            for (int reg = 0; reg < 4; ++reg) { const unsigned row = (unsigned)(row0 + 16 * mt + 4 * g + reg), ib = row * 512u + (unsigned)(h * 64 + n);
                rk[reg] = RKR[row * 8u + (unsigned)h];
#pragma unroll
                for (int nt = 0; nt < 4; ++nt) { yi[reg][nt] = YI[ib + 16 * nt]; vx[reg][nt] = VX[ib + 16 * nt]; gg[reg][nt] = __uint_as_float((unsigned)LW[row * 1536u + 1024u + (unsigned)(h * 64 + 16 * nt + n)] << 16); } }
#pragma unroll
            for (int reg = 0; reg < 4; ++reg) {
                const unsigned row = (unsigned)(row0 + 16 * mt + 4 * g + reg);
                float y[4], s = 0.f;
#pragma unroll
                for (int nt = 0; nt < 4; ++nt) { y[nt] = acc[mt][nt][reg] + yi[reg][nt]; s += y[nt]; }
                const float mean = row16_sum(s) * (1.0f / 64.0f); float v2 = 0.f;
#pragma unroll
                for (int nt = 0; nt < 4; ++nt) { y[nt] -= mean; v2 += y[nt] * y[nt]; }
                const float rstd = 1.0f / sqrtf(row16_sum(v2) * (1.0f / 64.0f) + GN_EPS);
#pragma unroll
                for (int nt = 0; nt < 4; ++nt) { const float ov = (y[nt] * rstd * lw[nt] + lb[nt] + rk[reg] * vx[reg][nt]) * gg[reg][nt];
                    MIX[(size_t)row * 1024 + 512 + h * 64 + 16 * nt + n] = (bf16)(pk2(ov, 0.f) & 0xffffu); }
            }
        }
}
__device__ __forceinline__ void decfin_row(const Args& a, int rid, int lane, float lam) {
    using namespace cfg;
    asm volatile("" : "+v"(lane));
    bf16* MIX = (bf16*)(a.ws + WS_MIX);
    const float* part = (const float*)(a.ws + WS_DPART); const float* ml = (const float*)(a.ws + WS_DML);
    {
        const int b = rid >> 6, h = (rid >> 4) & 3, q = rid & 15;
        const int p = lane & 15, c = (lane >> 4) & 1;
        const size_t pi = (size_t)(((b * 4 + h) * 2 + (p >> 3)) * 8 + (p & 7));
        const float mp = ml[pi * 64 + c * 32 + 2 * q], lp = ml[pi * 64 + c * 32 + 2 * q + 1];
        float pv[2][16][2];
#pragma unroll
        for (int cc = 0; cc < 2; ++cc)
#pragma unroll
            for (int pp = 0; pp < 16; ++pp) { const size_t pj = (size_t)(((b * 4 + h) * 2 + (pp >> 3)) * 8 + (pp & 7)) * 4096 + cc * 2048 + q * 128; pv[cc][pp][0] = part[pj + lane]; pv[cc][pp][1] = part[pj + 64 + lane]; }
        float mm = mp; mm = fmaxf(mm, __shfl_xor(mm, 1)); mm = fmaxf(mm, __shfl_xor(mm, 2)); mm = fmaxf(mm, __shfl_xor(mm, 4)); mm = fmaxf(mm, __shfl_xor(mm, 8));
        const float wgt = ex2(mp - mm); float L = lp * wgt; L += __shfl_xor(L, 1); L += __shfl_xor(L, 2); L += __shfl_xor(L, 4); L += __shfl_xor(L, 8);
        const float wn = wgt / L;
        float oc[2][2];
#pragma unroll
        for (int cc = 0; cc < 2; ++cc) { float o0 = 0.f, o1 = 0.f;
#pragma unroll
            for (int pp = 0; pp < 16; ++pp) { const float w_ = __shfl(wn, pp + 16 * cc); o0 += pv[cc][pp][0] * w_; o1 += pv[cc][pp][1] * w_; }
            oc[cc][0] = o0; oc[cc][1] = o1; }
        const float d0 = oc[0][0] - lam * oc[1][0], d1 = oc[0][1] - lam * oc[1][1];
        const float rstd = 1.0f / sqrtf(wave_sum(d0 * d0 + d1 * d1) * (1.0f / 128.0f) + NORM_EPS);
        bf16* dst = MIX + (size_t)(MPP + b * 16 + q) * 1024 + h * 128;
        dst[lane] = (bf16)(pk2(d0 * rstd * a.in[I_SUBLN][lane] * (1.0f - LAM_INIT), 0.f) & 0xffffu); dst[64 + lane] = (bf16)(pk2(d1 * rstd * a.in[I_SUBLN][64 + lane] * (1.0f - LAM_INIT), 0.f) & 0xffffu);
    }
}
__device__ __forceinline__ void ph_r3(const Args& a, int gw, int NGW, int lane, float lam, int mode = 3) {
    using namespace cfg;
    if (mode & 1) for (int u = gw; u < NT64 * 8; u += NGW) { const int h = u & 7, tl = u < 2048 ? 1 + (u >> 3) : (u < 2056 ? 0 : NCH + ((u - 2056) >> 3)); r3_unit(a, tl, h, lane); }
    if (mode & 2) for (int rid = gw; rid < DB * 4 * 16; rid += NGW) decfin_row(a, rid, lane, lam);
}

__device__ __forceinline__ int crow(int r, int hi) { return (r & 3) + 8 * (r >> 2) + 4 * hi; }
__device__ __forceinline__ s16x4 vtr(const LAS unsigned char* p) { return __builtin_bit_cast(s16x4, __builtin_amdgcn_ds_read_tr16_b64_v4i16((LAS v4i16_t*)p)); }
__device__ __forceinline__ void attn_unit(const Args& a, LAS unsigned char* lds, int h, int qt, float lam, int tid, int wave, int lane) {
    using namespace cfg;
    asm volatile("" : "+v"(lane), "+v"(tid));
    const bf16* Qb = (const bf16*)(a.ws + WS_QB); const bf16* Kb = (const bf16*)(a.ws + WS_KB); const bf16* Vb = (const bf16*)(a.ws + WS_VB); bf16* MIX = (bf16*)(a.ws + WS_MIX);
    LAS float* tb = (LAS float*)(lds + ATT_TB_OFF); LAS float* scr = (LAS float*)(lds + ATT_TB_OFF + 1024 + wave * 128);
    const int comp = wave >> 2, qg = wave & 3, r = lane & 31, hh = lane >> 5;
    const int ntile = 2 * qt + 2, my_nt = qg < 2 ? ntile - 1 : ntile, q0 = 128 * qt + 32 * qg;
    build_bias_table(tb, a.in[I_RELB], h, tid);
    bf16x8 qr[4];
#pragma unroll
    for (int d0 = 0; d0 < 4; ++d0) qr[d0] = *(const bf16x8*)(Qb + (size_t)(q0 + r) * 512 + h * 128 + comp * 64 + 16 * d0 + 8 * hh);
    f32x16 o[4];
#pragma unroll
    for (int eb = 0; eb < 4; ++eb)
#pragma unroll
        for (int x = 0; x < 16; ++x) o[eb][x] = 0.f;
    float l_run = 0.f;
    unsigned kso[2], vso[2];
#pragma unroll
    for (int i = 0; i < 2; ++i) { const int j = 2 * wave + i;
        { const int cmp = j >> 3, row = (j & 7) * 8 + (lane >> 3), pos = lane & 7, ch = pos ^ ((row >> 1) & 7); kso[i] = (unsigned)(row * 512 + h * 128 + cmp * 64 + ch * 8); }
        { const int row = j * 4 + (lane >> 4), p16 = lane & 15, ch = (((p16 >> 2) ^ (row & 3)) << 2) | (p16 & 3); vso[i] = (unsigned)(row * 512 + h * 128 + ch * 8); } }
    const unsigned lds0 = (unsigned)(uintptr_t)lds;
#define ATT_STAGE_K(kt, buf) do { _Pragma("unroll") for (int i_ = 0; i_ < 2; ++i_) \
        glds16(Kb + (size_t)(kt) * 32768 + kso[i_], (unsigned)__builtin_amdgcn_readfirstlane(lds0 + (buf) * 16384 + (2 * wave + i_) * 1024)); } while (0)
#define ATT_STAGE_V(kt, buf) do { _Pragma("unroll") for (int i_ = 0; i_ < 2; ++i_) \
        glds16(Vb + (size_t)(kt) * 32768 + vso[i_], (unsigned)__builtin_amdgcn_readfirstlane(lds0 + 65536 + (buf) * 16384 + (2 * wave + i_) * 1024)); } while (0)
#define ATT_STAGE_STEP(kt) do { if ((kt) + 3 < ntile) ATT_STAGE_K((kt) + 3, ((kt) + 3) & 3); else ATT_STAGE_K(0, ((kt) + 3) & 3); \
        if ((kt) + 2 < ntile) ATT_STAGE_V((kt) + 2, ((kt) + 2) & 3); else ATT_STAGE_V(0, ((kt) + 2) & 3); } while (0)
    const int li = lane & 15, cb = (lane >> 4) & 1, vq = li >> 2;
    const LAS unsigned char* vrd = lds + 65536 + (4 * hh + vq) * 256 + 32 * cb + 8 * (li & 3);
    const LAS unsigned char* vb_[4]; const LAS unsigned char* kb_[4];
#pragma unroll
    for (int x = 0; x < 4; ++x) { vb_[x] = vrd + ((x ^ vq) << 6); kb_[x] = lds + comp * 8192 + r * 128 + (((2 * x + hh) ^ ((r >> 1) & 7)) << 4); }
#define KRDS_(slot_, i_) (*(const LAS bf16x8*)(kb_[(i_) >> 1] + (slot_) * 16384 + ((i_) & 1) * 4096))
#define VRDS_(slot_, j_, lo_, hi_) do { const LAS unsigned char* ad_ = vb_[(j_) >> 2] + (slot_) * 16384 + ((j_) & 3) * 4096; lo_ = vtr(ad_); hi_ = vtr(ad_ + 8 * 256); } while (0)
#define ATT_QK(P0, P1, buf) do { const LAS unsigned char* Kc_ = lds + (buf) * 16384 + comp * 8192; \
        _Pragma("unroll") for (int d0 = 0; d0 < 4; ++d0) { const int ch_ = 2 * d0 + hh, r1_ = 32 + r; \
            const bf16x8 kf0_ = *(const LAS bf16x8*)(Kc_ + r * 128 + ((ch_ ^ ((r >> 1) & 7)) << 4)); \
            const bf16x8 kf1_ = *(const LAS bf16x8*)(Kc_ + r1_ * 128 + ((ch_ ^ ((r1_ >> 1) & 7)) << 4)); \
            if (d0 == 0) { f32x16 z_; _Pragma("unroll") for (int x_ = 0; x_ < 16; ++x_) z_[x_] = 0.f; P0 = MFMA32(kf0_, qr[0], z_); P1 = MFMA32(kf1_, qr[0], z_); } else { P0 = MFMA32(kf0_, qr[d0], P0); P1 = MFMA32(kf1_, qr[d0], P1); } } } while (0)
#define ATT_STATS(kt, p0, p1) do { \
        if ((kt) + 4 >= ntile || (kt) == 0) { asm volatile("s_nop 15" ::: "memory");     \
            const int base_ = 64 * (kt) - (q0 + r) + 191; const bool dead_ = (kt) >= my_nt; \
            _Pragma("unroll") for (int x = 0; x < 16; ++x) { const int k0 = crow(x, hh); int i0 = base_ + k0, i1 = base_ + 32 + k0; i0 = i0 < 0 ? 0 : (i0 > 255 ? 255 : i0); i1 = i1 < 0 ? 0 : (i1 > 255 ? 255 : i1); \
                p0[x] += tb[i0]; p1[x] += tb[i1]; \
                if (dead_ || ((kt) == 0 && k0 < FPAD)) p0[x] = -1e30f; if (dead_ || ((kt) == 0 && 32 + k0 < FPAD)) p1[x] = -1e30f; } } } while (0)
#define SBAR_() __builtin_amdgcn_sched_barrier(0)
#define MFMA_ACC_(acc_, a_, b_) asm volatile("v_mfma_f32_32x32x16_bf16 %0, %1, %2, %0" : "+v"(acc_) : "v"(a_), "v"(b_))
#define MFMA_NEW_(dst_, a_, b_) asm volatile("v_mfma_f32_32x32x16_bf16 %0, %1, %2, 0" : "=&v"(dst_) : "v"(a_), "v"(b_))
#define KRD_(i_) (*(const LAS bf16x8*)(Kc_ + ((i_) & 1 ? 32 + r : r) * 128 + (((2 * ((i_) >> 1) + hh) ^ ((((i_) & 1 ? 32 + r : r) >> 1) & 7)) << 4)))
#define VRD_(j_, lo_, hi_) do { const LAS unsigned char* ad_ = Vc_ + ((j_) & 3) * 4096 + ((((j_) >> 2) ^ vq) << 6); lo_ = vtr(ad_); hi_ = vtr(ad_ + 8 * 256); } while (0)
#define VFR_(lo_, hi_) ((bf16x8){lo_[0], lo_[1], lo_[2], lo_[3], hi_[0], hi_[1], hi_[2], hi_[3]})
#define EXPV_(P0, P1, i_) do { if ((i_) < 16) { float t_ = P0[(i_) & 15]; asm volatile("v_exp_f32 %0, %0" : "+v"(t_)); P0[(i_) & 15] = t_; } else { float t_ = P1[(i_) & 15]; asm volatile("v_exp_f32 %0, %0" : "+v"(t_)); P1[(i_) & 15] = t_; } } while (0)
#define ADDV_(s_, P0, P1, i_) do { const float t_ = (i_) < 16 ? P0[(i_) & 15] : P1[(i_) & 15]; asm volatile("v_add_f32 %0, %0, %1" : "+v"(s_) : "v"(t_)); } while (0)
#define PKV_(PN, P0, P1, k_) do { const float a_ = (k_) < 8 ? P0[(2 * (k_)) & 15] : P1[(2 * (k_)) & 15], b_ = (k_) < 8 ? P0[(2 * (k_) + 1) & 15] : P1[(2 * (k_) + 1) & 15]; unsigned d_; \
        asm volatile("v_cvt_pk_bf16_f32 %0, %1, %2" : "=v"(d_) : "v"(a_), "v"(b_)); v4u w_ = __builtin_bit_cast(v4u, PN[(k_) >> 2]); w_[(k_) & 3] = d_; PN[(k_) >> 2] = __builtin_bit_cast(bf16x8, w_); } while (0)
#define VRDB_(base_, j_, lo_, hi_) do { const LAS unsigned char* ad_ = (base_) + ((j_) & 3) * 4096 + ((((j_) >> 2) ^ vq) << 6); lo_ = vtr(ad_); hi_ = vtr(ad_ + 8 * 256); } while (0)
#define ATT_MAIN(kt, PH, p0, p1, n0, n1, pa, pn) do {     \
        bf16x8 kf_[3]; float s0_ = 0.f, s1_ = 0.f; \
        const int kk_ = (kt) + 3 < ntile ? (kt) + 3 : 0, vv_ = (kt) + 2 < ntile ? (kt) + 2 : 0;     \
        SBAR_(); \
          \
          \
        _Pragma("unroll") for (int g_ = 0; g_ < 24; ++g_) { \
            if (g_ < 14) VRDS_(((PH) + 3) & 3, g_ + 2, vl_[(g_ + 2) % 3], vh_[(g_ + 2) % 3]); else if (g_ < 22) kf_[(g_ - 14) % 3] = KRDS_(((PH) + 1) & 3, g_ - 14); else VRDS_((PH) & 3, g_ - 22, vl_[g_ - 22], vh_[g_ - 22]); \
            if (g_ < 16) { const bf16x8 vf_ = VFR_(vl_[g_ % 3], vh_[g_ % 3]); MFMA_ACC_(o[g_ >> 2], pa[g_ & 3], vf_); } \
            else if (g_ == 16) MFMA_NEW_(n0, kf_[0], qr[0]); else if (g_ == 17) MFMA_NEW_(n1, kf_[1], qr[0]); \
            else { if (g_ & 1) MFMA_ACC_(n1, kf_[(g_ - 16) % 3], qr[(g_ - 16) >> 1]); else MFMA_ACC_(n0, kf_[(g_ - 16) % 3], qr[(g_ - 16) >> 1]); } \
            if (g_ < 16) { EXPV_(p0, p1, 2 * g_); EXPV_(p0, p1, 2 * g_ + 1); } \
            if (g_ >= 1 && g_ <= 16) { ADDV_(s0_, p0, p1, 2 * g_ - 2); ADDV_(s1_, p0, p1, 2 * g_ - 1); } \
            if (g_ >= 16) { PKV_(pn, p0, p1, 2 * (g_ - 16)); PKV_(pn, p0, p1, 2 * (g_ - 16) + 1); } \
            if (g_ == 16 || g_ == 18) glds16s(Kb + (size_t)kk_ * 32768, 2u * kso[(g_ - 16) >> 1], (unsigned)__builtin_amdgcn_readfirstlane(lds0 + (((PH) + 3) & 3) * 16384 + (2 * wave + ((g_ - 16) >> 1)) * 1024)); \
            if (g_ == 20 || g_ == 22) glds16s(Vb + (size_t)vv_ * 32768, 2u * vso[(g_ - 20) >> 1], (unsigned)__builtin_amdgcn_readfirstlane(lds0 + 65536 + (((PH) + 2) & 3) * 16384 + (2 * wave + ((g_ - 20) >> 1)) * 1024)); \
            SBAR_(); } \
        l_run += s0_ + s1_; } while (0)
    ATT_STAGE_K(0, 0); ATT_STAGE_V(0, 0); ATT_STAGE_K(1, 1); ATT_STAGE_V(1, 1); ATT_STAGE_K(2, 2);
    { _Pragma("unroll") for (int i_ = 0; i_ < 2; ++i_)
        glds16(Vb + vso[i_], (unsigned)__builtin_amdgcn_readfirstlane(lds0 + 65536 + 3 * 16384 + (2 * wave + i_) * 1024)); }
    asm volatile("s_waitcnt vmcnt(0)" ::: "memory");
    __syncthreads();
    f32x16 p0, p1, n0, n1; bf16x8 pa[4], pn[4];
#pragma unroll
    for (int x = 0; x < 4; ++x) { pa[x] = (bf16x8){0, 0, 0, 0, 0, 0, 0, 0}; pn[x] = pa[x]; }
    ATT_QK(p0, p1, 0);
    s16x4 vl_[3], vh_[3];
    VRDB_(vrd + 3 * 16384, 0, vl_[0], vh_[0]); VRDB_(vrd + 3 * 16384, 1, vl_[1], vh_[1]);
    for (int kt = 0; kt < ntile; kt += 4) {
        ATT_STATS(kt, p0, p1);
        ATT_MAIN(kt, 0, p0, p1, n0, n1, pa, pn);
        asm volatile("s_waitcnt vmcnt(4)\n\ts_barrier" ::: "memory");
        ATT_STATS(kt + 1, n0, n1);
        ATT_MAIN(kt + 1, 1, n0, n1, p0, p1, pn, pa);
        asm volatile("s_waitcnt vmcnt(4)\n\ts_barrier" ::: "memory");
        if (kt + 2 >= ntile) break;
        ATT_STATS(kt + 2, p0, p1);
        ATT_MAIN(kt + 2, 2, p0, p1, n0, n1, pa, pn);
        asm volatile("s_waitcnt vmcnt(4)\n\ts_barrier" ::: "memory");
        ATT_STATS(kt + 3, n0, n1);
        ATT_MAIN(kt + 3, 3, n0, n1, p0, p1, pn, pa);
        asm volatile("s_waitcnt vmcnt(4)\n\ts_barrier" ::: "memory");
    }
    asm volatile("s_waitcnt vmcnt(0)" ::: "memory");
    { const LAS unsigned char* Vc_ = vrd + ((ntile - 1) & 3) * 16384;
#pragma unroll
      for (int eb = 0; eb < 4; ++eb)
#pragma unroll
          for (int ks = 0; ks < 4; ++ks) { const LAS unsigned char* ad_ = Vc_ + ks * 4096 + ((eb ^ vq) << 6); const s16x4 lo_ = vtr(ad_), hi_ = vtr(ad_ + 8 * 256);
              o[eb] = MFMA32(pa[ks], ((bf16x8){lo_[0], lo_[1], lo_[2], lo_[3], hi_[0], hi_[1], hi_[2], hi_[3]}), o[eb]); } }
#undef ATT_STAGE_K
#undef ATT_STAGE_V
#undef ATT_STAGE_STEP
#undef ATT_QK
#undef ATT_STATS
#undef ATT_MAIN
#undef SBAR_
#undef MFMA_ACC_
#undef MFMA_NEW_
#undef KRD_
#undef VRD_
#undef VRDB_
#undef KRDS_
#undef VRDS_
#undef VFR_
#undef EXPV_
#undef ADDV_
#undef PKV_
    l_run += __shfl_xor(l_run, 32);
    { const float sc = (comp ? lam : 1.0f) / l_run;
      if (hh == 0) scr[r] = sc;
      LDS_WAIT(); asm volatile("" ::: "memory");
#pragma unroll
      for (int g4 = 0; g4 < 4; ++g4) { const f32x4 al = *(const LAS f32x4*)(scr + 8 * g4 + 4 * hh);
#pragma unroll
          for (int eb = 0; eb < 4; ++eb) { o[eb][4 * g4] *= al.x; o[eb][4 * g4 + 1] *= al.y; o[eb][4 * g4 + 2] *= al.z; o[eb][4 * g4 + 3] *= al.w; } }
    }
    __syncthreads();
    LAS float* X = (LAS float*)lds + qg * 4096;
    if (comp == 1) {
#pragma unroll
        for (int eb = 0; eb < 4; ++eb)
#pragma unroll
            for (int x = 0; x < 16; ++x) X[crow(x, hh) * 128 + 32 * eb + r] = o[eb][x];
    }
    __syncthreads();
    if (comp == 0) {
#pragma unroll
        for (int eb = 0; eb < 4; ++eb)
#pragma unroll
            for (int x = 0; x < 16; ++x) { const int xi = crow(x, hh) * 128 + 32 * eb + r; X[xi] = o[eb][x] - X[xi]; }
    }
    __syncthreads();
    { const int row = tid >> 2, qtr = tid & 3; const LAS float* xr = (const LAS float*)lds + row * 128 + 32 * qtr;
      float d[32], ss = 0.f;
#pragma unroll
      for (int j4 = 0; j4 < 8; ++j4) { const f32x4 v = *(const LAS f32x4*)(xr + 4 * j4); d[4 * j4] = v.x; d[4 * j4 + 1] = v.y; d[4 * j4 + 2] = v.z; d[4 * j4 + 3] = v.w; ss += (v.x * v.x + v.y * v.y) + (v.z * v.z + v.w * v.w); }
      ss = quad_sum(ss);
      const float rstd = (1.0f - LAM_INIT) / sqrtf(ss * (1.0f / 128.0f) + NORM_EPS);
      const float* sg = a.in[I_SUBLN] + 32 * qtr;
      bf16* dst = MIX + (size_t)(128 * qt + row) * 1024 + h * 128 + 32 * qtr;
#pragma unroll
      for (int j8 = 0; j8 < 4; ++j8) { v4u w;
          w.x = pk2(d[8 * j8] * rstd * sg[8 * j8], d[8 * j8 + 1] * rstd * sg[8 * j8 + 1]); w.y = pk2(d[8 * j8 + 2] * rstd * sg[8 * j8 + 2], d[8 * j8 + 3] * rstd * sg[8 * j8 + 3]);
          w.z = pk2(d[8 * j8 + 4] * rstd * sg[8 * j8 + 4], d[8 * j8 + 5] * rstd * sg[8 * j8 + 5]); w.w = pk2(d[8 * j8 + 6] * rstd * sg[8 * j8 + 6], d[8 * j8 + 7] * rstd * sg[8 * j8 + 7]);
          *(v4u*)(dst + 8 * j8) = w; }
    }
    __syncthreads();
}
__device__ __forceinline__ void ph_attn(const Args& a, LAS unsigned char* lds, gu32* ctl, volatile LAS unsigned* misc, float lam, int tid, int wave, int lane) {
    LAS float* dtb = (LAS float*)(lds + ATT_TB_OFF + 2048);
    for (int hh = 0; hh < 4; ++hh) build_bias_table(dtb + 256 * hh, a.in[I_RELB], hh, tid);
    __syncthreads();
    const unsigned myh = xb_xcc_id() & 3u;
    for (;;) {
        if (tid == 0) { const unsigned t = __hip_atomic_fetch_add(ctl + CW_QATT, 1u, __ATOMIC_RELAXED, __HIP_MEMORY_SCOPE_AGENT); unsigned uu = 0u;
            if (t < 772u && !(t < 768u && t % 3u == 2u)) {
                for (unsigned k = 0; k < 4u; ++k) { const unsigned hq = (myh + k) & 3u; const unsigned j = __hip_atomic_fetch_add(ctl + CW_QH + 64 * hq, 1u, __ATOMIC_RELAXED, __HIP_MEMORY_SCOPE_AGENT);
                    if (j < 129u) { uu = 4u * j + hq; break; } } }
            misc[4] = t; misc[5] = uu; }
        __syncthreads();
        const unsigned it = (unsigned)__builtin_amdgcn_readfirstlane((int)misc[4]);
        const unsigned au = (unsigned)__builtin_amdgcn_readfirstlane((int)misc[5]);
        __syncthreads();
        if (it >= 772u + 265u + 256u) break;
        const int kind = it >= 772u + 265u ? 3 : it >= 772u ? 2 : (it < 768u && it % 3u == 2u) ? 1 : 0;
        if (tid == 0 && kind >= 2) { gu32* w = ctl + (kind == 3 ? CW_DECDONE : CW_R2DONE); const unsigned want = kind == 3 ? 256u : 32u; unsigned sp = 0;
            while (__hip_atomic_load(w, __ATOMIC_RELAXED, __HIP_MEMORY_SCOPE_AGENT) < want && ++sp < (1u << 22)) __builtin_amdgcn_s_sleep(8);
            __builtin_amdgcn_fence(__ATOMIC_ACQUIRE, "agent"); asm volatile("s_waitcnt vmcnt(0)" ::: "memory"); }
        __syncthreads();
        if (kind == 0) attn_unit(a, lds, (int)(au & 3u), 128 - (int)(au >> 2), lam, tid, wave, lane);
        else if (kind == 1) { const unsigned du = it / 3u; dec_attn_unit(a, lds, dtb + 256 * ((du >> 1) & 3), (int)du, wave, lane); }
        else if (kind == 2) { const unsigned bi = it - 772u; const int tl = bi < 256u ? 1 + (int)bi : (bi == 256u ? 0 : cfg::NCH + (int)(bi - 257u)); r3_unit(a, tl, wave, lane); }
        else decfin_row(a, (int)(it - 772u - 265u) * 8 + wave, lane, lam);
        asm volatile("s_waitcnt vmcnt(0)" ::: "memory");
        __syncthreads();
        if (tid == 0 && kind == 1) { __builtin_amdgcn_fence(__ATOMIC_RELEASE, "agent"); asm volatile("s_waitcnt vmcnt(0)" ::: "memory"); (void)__hip_atomic_fetch_add(ctl + CW_DECDONE, 1u, __ATOMIC_RELAXED, __HIP_MEMORY_SCOPE_AGENT); }
    }
}

__device__ __forceinline__ void ph_norm2(const Args& a, int gw, int NGW, int lane) {
    const float* X1 = (const float*)(a.ws + WS_X1); bf16* XN = (bf16*)(a.ws + WS_XN);
    for (int m = gw; m < cfg::M; m += NGW) rms_row_bf16(X1 + (size_t)m * 1024, a.in[I_LN2], XN + (size_t)m * 1024, lane);
}
__device__ __forceinline__ void ph_conv(const Args& a, int gw, int NGW, int lane) {
    using namespace cfg;
    const bf16* Z = (const bf16*)(a.ws + WS_Z); bf16* ACT = (bf16*)(a.ws + WS_ACT);
    const float* cw = a.in[I_CONVW]; const float* cbias = a.in[I_CONVB]; const float* sconv = a.in[I_SCV];
    constexpr int NSEGP = MP / 8, NSEG = NSEGP + MD / 8, NLI = NSEG * 352;
    for (int li = gw * 64 + lane; li < NLI; li += NGW * 64) {
        const int seg = li / 352, cg = li - seg * 352, r0 = seg < NSEGP ? 8 * seg : MPP + 8 * (seg - NSEGP);
        const int c8 = cg * 8;
        const bool dec = r0 >= MPP; const int t0 = dec ? ((r0 - MPP) & 15) : 0, b = dec ? ((r0 - MPP) >> 4) : 0;
        v4u zr[10][2];
        f32x4 hs[2][2][2];
        const bool use_state = dec && t0 == 0, zero_halo = !dec && r0 == 0;
#pragma unroll
        for (int j = 0; j < 10; ++j) { const int row = r0 - 2 + j;
            if (j >= 2 || !(use_state || zero_halo)) { zr[j][0] = *(const v4u*)(Z + (size_t)row * NUP + c8); zr[j][1] = *(const v4u*)(Z + (size_t)row * NUP + DFF + c8); }
            else { zr[j][0] = (v4u){0u, 0u, 0u, 0u}; zr[j][1] = zr[j][0]; } }
        if (use_state) {
#pragma unroll
            for (int j = 0; j < 2; ++j)
#pragma unroll
                for (int hf = 0; hf < 2; ++hf) { const float* sr = sconv + ((size_t)b * 2 + j) * NUP + hf * DFF + c8; hs[j][hf][0] = *(const f32x4*)sr; hs[j][hf][1] = *(const f32x4*)(sr + 4); }
        }
        float wv[3][2][8], bv[2][8];
#pragma unroll
        for (int hf = 0; hf < 2; ++hf) { const f32x4 b0 = *(const f32x4*)(cbias + hf * DFF + c8), b1 = *(const f32x4*)(cbias + hf * DFF + c8 + 4);
            bv[hf][0] = b0.x; bv[hf][1] = b0.y; bv[hf][2] = b0.z; bv[hf][3] = b0.w; bv[hf][4] = b1.x; bv[hf][5] = b1.y; bv[hf][6] = b1.z; bv[hf][7] = b1.w;
#pragma unroll
            for (int j = 0; j < 3; ++j) { const f32x4 w0 = *(const f32x4*)(cw + (size_t)j * NUP + hf * DFF + c8), w1 = *(const f32x4*)(cw + (size_t)j * NUP + hf * DFF + c8 + 4);
                wv[j][hf][0] = w0.x; wv[j][hf][1] = w0.y; wv[j][hf][2] = w0.z; wv[j][hf][3] = w0.w; wv[j][hf][4] = w1.x; wv[j][hf][5] = w1.y; wv[j][hf][6] = w1.z; wv[j][hf][7] = w1.w; } }
        float z2[2][8], z1[2][8], z0[2][8];
#pragma unroll
        for (int hf = 0; hf < 2; ++hf) {
            if (use_state) {
#pragma unroll
                for (int e = 0; e < 4; ++e) { z2[hf][e] = hs[0][hf][0][e]; z2[hf][4 + e] = hs[0][hf][1][e]; z1[hf][e] = hs[1][hf][0][e]; z1[hf][4 + e] = hs[1][hf][1][e]; } }
            else { unpack8(zr[0][hf], z2[hf]); unpack8(zr[1][hf], z1[hf]); }
        }
#pragma unroll
        for (int t = 0; t < 8; ++t) {
            unpack8(zr[2 + t][0], z0[0]); unpack8(zr[2 + t][1], z0[1]);
            float act[8];
#pragma unroll
            for (int e = 0; e < 8; ++e) {
                const float gt = bv[0][e] + z2[0][e] * wv[0][0][e] + z1[0][e] * wv[1][0][e] + z0[0][e] * wv[2][0][e];
                const float up = bv[1][e] + z2[1][e] * wv[0][1][e] + z1[1][e] * wv[1][1][e] + z0[1][e] * wv[2][1][e];
                act[e] = gt * sigm(gt) * up;
            }
            v4u w; w.x = pk2(act[0], act[1]); w.y = pk2(act[2], act[3]); w.z = pk2(act[4], act[5]); w.w = pk2(act[6], act[7]);
            *(v4u*)(ACT + (size_t)(r0 + t) * DFF + c8) = w;
            if (t >= 6) {
                float* cd = nullptr;
                if (r0 + 7 == MP - 1) cd = a.out + O_CP + (size_t)(t - 6) * NUP; else if (dec && t0 == 8) cd = a.out + O_CS + ((size_t)b * 2 + (t - 6)) * NUP;
                if (cd) {
#pragma unroll
                    for (int hf = 0; hf < 2; ++hf) { *(f32x4*)(cd + hf * DFF + c8) = (f32x4){z0[hf][0], z0[hf][1], z0[hf][2], z0[hf][3]}; *(f32x4*)(cd + hf * DFF + c8 + 4) = (f32x4){z0[hf][4], z0[hf][5], z0[hf][6], z0[hf][7]}; }
                }
            }
#pragma unroll
            for (int hf = 0; hf < 2; ++hf)
#pragma unroll
                for (int e = 0; e < 8; ++e) { z2[hf][e] = z1[hf][e]; z1[hf][e] = z0[hf][e]; }
        }
    }
}

__device__ __forceinline__ void ph_convfix(const Args& a, int gw, int NGW, int lane) {
    using namespace cfg;
    const bf16* Z = (const bf16*)(a.ws + WS_Z); bf16* ACT = (bf16*)(a.ws + WS_ACT);
    const float* cw = a.in[I_CONVW]; const float* cbias = a.in[I_CONVB]; const float* sconv = a.in[I_SCV];
    constexpr int NB = 256 + DB, NLI = NB * 352;
    for (int li = gw * 64 + lane; li < NLI; li += NGW * 64) {
        const int bi = li / 352, cg = li - bi * 352, c8 = 8 * cg, zc = 256 * (c8 >> 7) + (c8 & 127);
        const bool dec = bi >= 256; const int b = bi - 256, r0 = dec ? MPP + 16 * b : 64 * (bi + 1);
        float zz[4][2][8];
#pragma unroll
        for (int j = 0; j < 4; ++j)
#pragma unroll
            for (int hf = 0; hf < 2; ++hf) {
                if (j < 2 && dec) { const float* sr = sconv + ((size_t)b * 2 + j) * NUP + hf * DFF + c8; const f32x4 s0 = *(const f32x4*)sr, s1 = *(const f32x4*)(sr + 4);
                    zz[j][hf][0] = s0.x; zz[j][hf][1] = s0.y; zz[j][hf][2] = s0.z; zz[j][hf][3] = s0.w; zz[j][hf][4] = s1.x; zz[j][hf][5] = s1.y; zz[j][hf][6] = s1.z; zz[j][hf][7] = s1.w; }
                else unpack8(*(const v4u*)(Z + (size_t)(r0 - 2 + j) * NUP + zc + 128 * hf), zz[j][hf]); }
        float wv[3][2][8], bv[2][8];
#pragma unroll
        for (int hf = 0; hf < 2; ++hf) { const f32x4 b0 = *(const f32x4*)(cbias + hf * DFF + c8), b1 = *(const f32x4*)(cbias + hf * DFF + c8 + 4);
            bv[hf][0] = b0.x; bv[hf][1] = b0.y; bv[hf][2] = b0.z; bv[hf][3] = b0.w; bv[hf][4] = b1.x; bv[hf][5] = b1.y; bv[hf][6] = b1.z; bv[hf][7] = b1.w;
#pragma unroll
            for (int j = 0; j < 3; ++j) { const f32x4 w0 = *(const f32x4*)(cw + (size_t)j * NUP + hf * DFF + c8), w1 = *(const f32x4*)(cw + (size_t)j * NUP + hf * DFF + c8 + 4);
                wv[j][hf][0] = w0.x; wv[j][hf][1] = w0.y; wv[j][hf][2] = w0.z; wv[j][hf][3] = w0.w; wv[j][hf][4] = w1.x; wv[j][hf][5] = w1.y; wv[j][hf][6] = w1.z; wv[j][hf][7] = w1.w; } }
#pragma unroll
        for (int t = 0; t < 2; ++t) { float act[8];
#pragma unroll
            for (int e = 0; e < 8; ++e) {
                const float gt = bv[0][e] + zz[t][0][e] * wv[0][0][e] + zz[t + 1][0][e] * wv[1][0][e] + zz[t + 2][0][e] * wv[2][0][e];
                const float up = bv[1][e] + zz[t][1][e] * wv[0][1][e] + zz[t + 1][1][e] * wv[1][1][e] + zz[t + 2][1][e] * wv[2][1][e];
                act[e] = gt * sigm(gt) * up; }
            v4u w; w.x = pk2(act[0], act[1]); w.y = pk2(act[2], act[3]); w.z = pk2(act[4], act[5]); w.w = pk2(act[6], act[7]);
            *(v4u*)(ACT + (size_t)(r0 + t) * DFF + c8) = w; }
    }
}

template <class Fin>
__device__ __forceinline__ void gemm_small(LAS unsigned char* lds, const bf16* A, const bf16* Bt, int K, int piece, int tid, int wave, int lane, const Fin& fin) {
    asm volatile("" : "+v"(lane), "+v"(tid));
    const int rb = piece >> 4, cb = piece & 15;
    const int row0 = rb == 0 ? 16384 : cfg::MPP + 64 * (rb - 1), col0 = 64 * cb;
    const int fr = lane & 15, fq = lane >> 4;
    const int kw = K >> 3, k0 = wave * kw;
    f32x4 acc[4][4];
#pragma unroll
    for (int m = 0; m < 4; ++m)
#pragma unroll
        for (int n = 0; n < 4; ++n) acc[m][n] = (f32x4){0.f, 0.f, 0.f, 0.f};
    const bf16* ap = A + (size_t)(row0 + fr) * K + k0 + 8 * fq;
    const bf16* bp = Bt + (size_t)(col0 + fr) * K + k0 + 8 * fq;
#pragma unroll 1
    for (int ks = 0; ks < kw; ks += 128) {
        bf16x8 af[4][4], bf[4][4];
#pragma unroll
        for (int j = 0; j < 4; ++j) { const int kk = ks + 32 * j < kw ? ks + 32 * j : 0;
#pragma unroll
            for (int m = 0; m < 4; ++m) { af[j][m] = *(const bf16x8*)(ap + (size_t)(16 * m) * K + kk); bf[j][m] = *(const bf16x8*)(bp + (size_t)(16 * m) * K + kk); } }
#pragma unroll
        for (int j = 0; j < 4; ++j) if (ks + 32 * j < kw) {
#pragma unroll
            for (int m = 0; m < 4; ++m)
#pragma unroll
                for (int n = 0; n < 4; ++n) acc[m][n] = MFMA16(bf[j][n], af[j][m], acc[m][n]); }
    }
    LAS unsigned char* part = lds + wave * 16384;
#pragma unroll
    for (int m = 0; m < 4; ++m)
#pragma unroll
        for (int n = 0; n < 4; ++n) *(LAS f32x4*)(part + (16 * m + fr) * 256 + (((4 * n + fq) ^ fr) << 4)) = acc[m][n];
    __syncthreads();
    { const int row = tid >> 3, c8 = tid & 7; float v[8];
#pragma unroll
      for (int e = 0; e < 8; ++e) v[e] = 0.f;
#pragma unroll
      for (int w = 0; w < 8; ++w) { const f32x4 x0 = *(const LAS f32x4*)(lds + w * 16384 + row * 256 + (((2 * c8) ^ (row & 15)) << 4)), x1 = *(const LAS f32x4*)(lds + w * 16384 + row * 256 + (((2 * c8 + 1) ^ (row & 15)) << 4));
          v[0] += x0.x; v[1] += x0.y; v[2] += x0.z; v[3] += x0.w; v[4] += x1.x; v[5] += x1.y; v[6] += x1.z; v[7] += x1.w; }
      fin(row0 + row, col0 + 8 * c8, v); }
    __syncthreads();
}
struct FinX1 {
    const float* xp; const float* xs; const float* meta; float* X1; bf16* XB; unsigned long long* SSQ; const float* gain;
    __device__ __forceinline__ void operator()(int r, int c, const float (&v)[8]) const {
        const f32x4 g0 = *(const f32x4*)(gain + c), g1 = *(const f32x4*)(gain + c + 4);
        const float* src = pg8::x_src_row(r, xp, xs, meta) + c; float* dst = X1 + (size_t)r * cfg::DM + c;
        const f32x4 s0 = *(const f32x4*)src, s1 = *(const f32x4*)(src + 4);
        const f32x4 y0 = (f32x4){s0.x + v[0], s0.y + v[1], s0.z + v[2], s0.w + v[3]}, y1 = (f32x4){s1.x + v[4], s1.y + v[5], s1.z + v[6], s1.w + v[7]};
        *(f32x4*)dst = y0; *(f32x4*)(dst + 4) = y1;
        v4u w; w.x = pk2(y0.x * g0.x, y0.y * g0.y); w.y = pk2(y0.z * g0.z, y0.w * g0.w); w.z = pk2(y1.x * g1.x, y1.y * g1.y); w.w = pk2(y1.z * g1.z, y1.w * g1.w); *(v4u*)(XB + (size_t)r * cfg::DM + c) = w;
        float ss = ((y0.x * y0.x + y0.y * y0.y) + (y0.z * y0.z + y0.w * y0.w)) + ((y1.x * y1.x + y1.y * y1.y) + (y1.z * y1.z + y1.w * y1.w));
        ss += __shfl_xor(ss, 1); ss += __shfl_xor(ss, 2); ss += __shfl_xor(ss, 4);
        if ((threadIdx.x & 7) == 0) (void)__hip_atomic_fetch_add(SSQ + r, (unsigned long long)(ss * 16777216.0f), __ATOMIC_RELAXED, __HIP_MEMORY_SCOPE_AGENT);
    }
};
struct FinY {
    const float* X1; float* out;
    __device__ __forceinline__ void operator()(int r, int c, const float (&v)[8]) const {
        using namespace cfg;
        float* dst = (r < MP ? out + O_YP + (size_t)(r - FPAD - NMETA) * DM : out + O_YS + (size_t)(r - MPP) * DM) + c; const float* src = X1 + (size_t)r * DM + c;
        const f32x4 s0 = *(const f32x4*)src, s1 = *(const f32x4*)(src + 4);
        *(f32x4*)dst = (f32x4){s0.x + v[0], s0.y + v[1], s0.z + v[2], s0.w + v[3]}; *(f32x4*)(dst + 4) = (f32x4){s1.x + v[4], s1.y + v[5], s1.z + v[6], s1.w + v[7]};
    }
};

template <int PMASK> __global__ void __launch_bounds__(NWAVES * 64, 2) mk_fwd(Args args) {
    extern __shared__ __attribute__((aligned(16))) unsigned char lds_raw[];
    using namespace cfg;
    LAS unsigned char* lds = (LAS unsigned char*)lds_raw;
    volatile LAS unsigned* MISC = (volatile LAS unsigned*)(lds + MISC_OFF);
    const int tid = threadIdx.x, lane = tid & 63, wave = __builtin_amdgcn_readfirstlane(tid >> 6);
    const int G = gridDim.x, bx = blockIdx.x, vcu = (G % 8 == 0) ? (bx % 8) * (G / 8) + bx / 8 : bx;
    const int gw = vcu * NWAVES + wave, NGW = G * NWAVES;
    gu32* ctl = (gu32*)(args.ws + WS_CTL);
    for (int u = tid; u < (LDS_BYTES - LDSCTL_OFF) / 4; u += NWAVES * 64) ((LAS unsigned*)(lds + LDSCTL_OFF))[u] = 0u;
    __syncthreads();
    XcdBarrier bar; bar.bar = (unsigned*)(ctl + CW_BAR) + args.li * XCD_BAR_WORDS; bar.x = 0; bar.st = nullptr;
    if (N_LAUNCHES != N_PHASES) bar = xcd_barrier_post((unsigned*)(ctl + CW_BAR) + args.li * XCD_BAR_WORDS, MISC + 8);
#define GRID_BAR() do { if (N_LAUNCHES != N_PHASES) xcd_barrier(bar); } while (0)
    const int lo = args.ph_lo, hi = args.ph_hi;
#define IN(k) (((PMASK >> (k)) & 1) && lo <= (k) && (k) < hi)
#define BOTH(k) (IN(k) && IN((k) + 1))
#ifndef REP_PHASE
#define REP_PHASE -1
#endif
#define NREP(k) ((k) == REP_PHASE ? 2 : 1)
#define LAMBDA() (expf(wave_sum(args.in[I_LQ1][lane] * args.in[I_LK1][lane])) - expf(wave_sum(args.in[I_LQ2][lane] * args.in[I_LK2][lane])) + LAM_INIT)

    if (IN(0)) for (int rep = 0; rep < NREP(0); ++rep) { ph_prologue(args, lds, gw, NGW, wave, lane); if (BOTH(0)) GRID_BAR(); }
    if (IN(1)) for (int rep = 0; rep < NREP(1); ++rep) {
        pg8::Gemm g{(const pg8::bf16_t*)(args.ws + WS_XN), (const pg8::bf16_t*)(args.ws + WS_WIN), M, NPROJ, DM}; pg8::StaticOrder S; S.init(M, NPROJ, G, bx);
        pg8::EpiBf E{(pg8::bf16_t*)(args.ws + WS_PROJ), NPROJ};
        pg8::gemm_phase<pg8::EpiBf, pg8::StaticOrder, true, true>(lds + RING_OFF, g, S, E);
        if (BOTH(1)) GRID_BAR();
    }
    if (IN(2)) for (int rep = 0; rep < NREP(2); ++rep) { ph_rowpass(args, gw, NGW, lane); if (BOTH(2)) GRID_BAR(); }
    if (IN(3)) for (int rep = 0; rep < NREP(3); ++rep) {
        pg8::Gemm g{(const pg8::bf16_t*)(args.ws + WS_LIN), (const pg8::bf16_t*)(args.ws + WS_WLT), M, 1536, 256}; pg8::StaticOrder S; S.init(M, 1536, G, bx);
        pg8::EpiBf E{(pg8::bf16_t*)(args.ws + WS_LW), 1536};
        pg8::gemm_phase<pg8::EpiBf, pg8::StaticOrder, true, true>(lds + RING_OFF, g, S, E);
        if (BOTH(3)) GRID_BAR();
    }
    if (IN(4)) for (int rep = 0; rep < NREP(4); ++rep) { ph_r1(args, lds, bx, G, tid, wave, lane); if (rep == 0 && bx >= 66 && G > 66) { __syncthreads(); late_weights(args, lds, (bx - 66) * NWAVES + wave, (G - 66) * NWAVES, wave, lane); } if (BOTH(4)) GRID_BAR(); }
    if (IN(5)) for (int rep = 0; rep < NREP(5); ++rep) { const float lam = LAMBDA(); if (bx < 32) ph_r2(args, lds, bx, wave, lane, ctl + 256 * rep + CW_R2DONE); __syncthreads(); ph_attn(args, lds, ctl + 256 * rep, MISC, lam, tid, wave, lane); if (IN(5) && IN(8)) GRID_BAR(); }
    if (IN(8)) for (int rep = 0; rep < NREP(8); ++rep) {
        pg8::Gemm g{(const pg8::bf16_t*)(args.ws + WS_MIX), (const pg8::bf16_t*)(args.ws + WS_WOUT), 16384, DM, DM}; pg8::StaticOrder S; S.init(16384, DM, G, bx);
        unsigned long long* SSQ = (unsigned long long*)(args.ws + WS_CTL + WS_SSQ_OFF);
        pg8::EpiX1 E{args.in[I_XP], args.in[I_XS], args.in[I_META], (float*)(args.ws + WS_X1), (pg8::bf16_t*)(args.ws + WS_XN), SSQ, args.in[I_LN2]};
        pg8::gemm_phase<pg8::EpiX1, pg8::StaticOrder, true, true>(lds + RING_OFF, g, S, E);
        { const FinX1 F{args.in[I_XP], args.in[I_XS], args.in[I_META], (float*)(args.ws + WS_X1), (bf16*)(args.ws + WS_XN), SSQ, args.in[I_LN2]};
          for (int pc = bx; pc < 144; pc += G) gemm_small(lds, (const bf16*)(args.ws + WS_MIX), (const bf16*)(args.ws + WS_WOUT), DM, pc, tid, wave, lane, F);
          if (bx >= 144 || G <= 144) { float* zp = (float*)(args.ws + WS_X1) + (size_t)MP * DM; const int nz = (MPP - MP) * DM / 4, zb = G > 144 ? bx - 144 : bx, zn = G > 144 ? G - 144 : G;
              for (int i = zb * (NWAVES * 64) + tid; i < nz; i += zn * (NWAVES * 64)) ((f32x4*)zp)[i] = (f32x4){0.f, 0.f, 0.f, 0.f};
              f32x4* zq = (f32x4*)((bf16*)(args.ws + WS_XN) + (size_t)MP * DM); for (int i = zb * (NWAVES * 64) + tid; i < nz / 2; i += zn * (NWAVES * 64)) zq[i] = (f32x4){0.f, 0.f, 0.f, 0.f}; } }
        if (BOTH(8)) GRID_BAR();
    }
    if (IN(10)) for (int rep = 0; rep < NREP(10); ++rep) {
        pg8::Gemm g{(const pg8::bf16_t*)(args.ws + WS_XN), (const pg8::bf16_t*)(args.ws + WS_WUP), M, NUP, DM}; pg8::StaticOrder S; S.init(M, NUP, G, bx);
        pg8::EpiConv E{(pg8::bf16_t*)(args.ws + WS_Z), (pg8::bf16_t*)(args.ws + WS_ACT), (const unsigned long long*)(args.ws + WS_CTL + WS_SSQ_OFF), args.in[I_CONVW], args.in[I_CONVB], args.out};
        pg8::gemm_phase<pg8::EpiConv, pg8::StaticOrder, true, true>(lds + RING_OFF, g, S, E);
        if (BOTH(10)) GRID_BAR();
    }
    if (IN(11)) for (int rep = 0; rep < NREP(11); ++rep) { ph_convfix(args, gw, NGW, lane); if (BOTH(11)) GRID_BAR(); }
    if (IN(12)) for (int rep = 0; rep < NREP(12); ++rep) {
        pg8::Gemm g{(const pg8::bf16_t*)(args.ws + WS_ACT), (const pg8::bf16_t*)(args.ws + WS_WDN), 16384, DM, DFF}; pg8::StaticOrder S; S.init(16384, DM, G, bx);
        pg8::EpiY E{(const float*)(args.ws + WS_X1), args.out};
        pg8::gemm_phase<pg8::EpiY, pg8::StaticOrder, true, true>(lds + RING_OFF, g, S, E);
        { const FinY F{(const float*)(args.ws + WS_X1), args.out};
          for (int pc = bx; pc < 144; pc += G) gemm_small(lds, (const bf16*)(args.ws + WS_ACT), (const bf16*)(args.ws + WS_WDN), DFF, pc, tid, wave, lane, F); }
        if (rep + 1 < NREP(12)) GRID_BAR();
    }
#undef IN
#undef BOTH
#undef GRID_BAR
}


#ifndef PH_MASK
#define PH_MASK 0x1fff
#endif
template <int K> struct PhaseKernels {
    static hipError_t set_attr() { hipError_t e = hipFuncSetAttribute((const void*)mk_fwd<(1 << K)>, hipFuncAttributeMaxDynamicSharedMemorySize, LDS_BYTES); if (e != hipSuccess) return e; return PhaseKernels<K - 1>::set_attr(); }
    static void launch(int li, int grid, hipStream_t stream, const Args& a) { if (li == K) hipLaunchKernelGGL(mk_fwd<(1 << K)>, dim3(grid), dim3(NWAVES * 64), LDS_BYTES, stream, a); else PhaseKernels<K - 1>::launch(li, grid, stream, a); }
};
template <> struct PhaseKernels<-1> { static hipError_t set_attr() { return hipSuccess; } static void launch(int, int, hipStream_t, const Args&) {} };
static hipError_t set_lds_attr() {
    if constexpr (N_LAUNCHES == 1) return hipFuncSetAttribute((const void*)mk_fwd<PH_MASK>, hipFuncAttributeMaxDynamicSharedMemorySize, LDS_BYTES);
    else return PhaseKernels<N_PHASES - 1>::set_attr();
}
static void launch_one(int li, int grid, hipStream_t stream, const Args& a) {
    if constexpr (N_LAUNCHES == 1) hipLaunchKernelGGL(mk_fwd<PH_MASK>, dim3(grid), dim3(NWAVES * 64), LDS_BYTES, stream, a);
    else PhaseKernels<N_PHASES - 1>::launch(li, grid, stream, a);
}
extern "C" void kernel_launch(void* const* d_in, const int* in_sizes, int n_in, void* d_out, int out_size, void* d_ws, size_t ws_size, hipStream_t stream) {
    static int grid = 0;
    if (grid == 0) {
        if (n_in != 35 || out_size != (int)cfg::O_END || ws_size < WS_END) { fprintf(stderr, "kernel_launch: unexpected shapes: n_in %d out %d ws %zu (need %zu); nothing launched\n", n_in, out_size, ws_size, (size_t)WS_END); grid = -1; return; }
        int dev = 0, cus = 0;
        if (hipGetDevice(&dev) != hipSuccess || hipDeviceGetAttribute(&cus, hipDeviceAttributeMultiprocessorCount, dev) != hipSuccess) { fprintf(stderr, "kernel_launch: device query failed\n"); grid = -1; return; }
        if (set_lds_attr() != hipSuccess) { fprintf(stderr, "kernel_launch: hipFuncSetAttribute failed\n"); grid = -1; return; }
        (void)hipGetLastError();
        grid = cus;
        if (grid < 32) { fprintf(stderr, "kernel_launch: needs >= 32 CUs\n"); grid = -1; return; }
    }
    if (grid < 0) return;
    if (hipMemsetAsync((char*)d_ws + WS_CTL, 0, CTL_ZERO_BYTES, stream) != hipSuccess) { fprintf(stderr, "kernel_launch: memset failed\n"); return; }
    Args a{};
    for (int i = 0; i < 35; ++i) a.in[i] = (const float*)d_in[i];
    a.out = (float*)d_out; a.ws = (unsigned char*)d_ws;
    static_assert(N_LAUNCHES == 1 || N_LAUNCHES == N_PHASES, "MK_N_LAUNCHES: 1 or 13");
    for (int li = 0; li < N_LAUNCHES; ++li) {
        a.ph_lo = (N_LAUNCHES == 1) ? 0 : li; a.ph_hi = (N_LAUNCHES == 1) ? N_PHASES : li + 1; a.li = (N_LAUNCHES == 1) ? 0 : 0;
        launch_one(li, grid, stream, a);
        const hipError_t le = hipPeekAtLastError();
        if (le != hipSuccess) { fprintf(stderr, "kernel_launch: launch %d failed: %s\n", li, hipGetErrorName(le)); break; }
    }
}
```

```cpp
#include <hip/hip_runtime.h>
#include <hip/hip_bf16.h>
#include <cstdio>
#include <cstdint>
#include <cmath>

#ifndef R3_MODE
#define R3_MODE 3
#endif
#ifndef MK_N_LAUNCHES
#define MK_N_LAUNCHES 1
#endif

namespace cfg {
constexpr int DM = 1024, SEQ = 16384, NMETA = 16, FPAD = 48;
constexpr int MP = FPAD + NMETA + SEQ;
constexpr int MPP = 16640;
constexpr int DB = 32, DT = 16, MD = DB * DT;
constexpr int M = MPP + MD;
constexpr int NCK = 4112;
constexpr int DA = 512, NPR = 1792, NPROJ = 3328, DFF = 2816, NUP = 5632, PR0 = 1536;
constexpr int NCH = 257;
constexpr int NT64 = 265;
constexpr float NORM_EPS = 1e-6f, GN_EPS = 64e-5f, LAM_INIT = 0.2f;
constexpr float QSCALE = 0.125f * 1.4426950408889634f;
constexpr size_t O_YP = 0, O_YS = O_YP + (size_t)SEQ * DM, O_KP = O_YS + (size_t)MD * DM, O_VP = O_KP + (size_t)(NMETA + SEQ) * 512,
    O_SP = O_VP + (size_t)(NMETA + SEQ) * 512, O_HP = O_SP + 8 * 4096, O_CP = O_HP + NPR, O_KS = O_CP + 2 * NUP, O_VS = O_KS + (size_t)MD * 512,
    O_SS = O_VS + (size_t)MD * 512, O_HS = O_SS + (size_t)DB * 8 * 4096, O_CS = O_HS + (size_t)DB * NPR, O_END = O_CS + (size_t)DB * 2 * NUP;
static_assert(O_END == 36131584, "output size");
}
namespace pg8 {
#define PG8_LAS __attribute__((address_space(3)))
typedef unsigned short bf16_t;
typedef short bf16x8 __attribute__((ext_vector_type(8)));
typedef float f32x4 __attribute__((ext_vector_type(4)));
typedef unsigned u32x4 __attribute__((ext_vector_type(4)));
constexpr int BM = 256, BK = 64, HALF = 128, HTB = HALF * BK * 2  , STAGE_BYTES = 8 * HTB, NXCD = 8, WGM = 8;

__host__ __device__ __forceinline__ int lds_byte(int r, int c) { const int st = (r >> 4) * 2 + (c >> 5), rr = r & 15, cc = c & 31, ob = rr * 64 + cc * 2; return st * 1024 + (ob ^ (((ob >> 9) & 1) << 5)); }
__host__ __device__ __forceinline__ void stage_rc(int b, int& R, int& C) { const int st = b / 1024, sb = b % 1024, swz = sb ^ (((sb >> 9) & 1) << 5); R = (st >> 1) * 16 + swz / 64; C = (st & 1) * 32 + (swz % 64) / 2; }
__host__ __device__ __forceinline__ int perm32(int rho) { const int n = rho >> 4, i = rho & 15; return 8 * (i >> 2) + 4 * n + (i & 3); }

struct Unit { int pm, pn; };
struct Gemm { const bf16_t* A; const bf16_t* Bt; int M, N, K; };

struct StaticOrder {
    int nM, nN, nwg, G, c;
    __host__ __device__ void init(int M, int N, int G_, int c_) { nM = M / BM; nN = N / BM; nwg = nM * nN; G = G_; c = c_; }
    __host__ __device__ bool next(int i, Unit& u) const {
        const long L = (long)i * G + c; if (L >= nwg) return false;
        int wgid = (int)L; { const int q = nwg / NXCD, r = nwg % NXCD, xcd = wgid % NXCD, off = wgid / NXCD; wgid = (xcd < r ? xcd * (q + 1) : r * (q + 1) + (xcd - r) * q) + off; }
        const int nig = WGM * nN, gid = wgid / nig, fm = gid * WGM, gsz = (nM - fm) < WGM ? (nM - fm) : WGM;
        u.pm = fm + ((wgid % nig) % gsz); u.pn = (wgid % nig) / gsz; return true;
    }
    __device__ __forceinline__ void a_ready(const Unit&) const {}
    __device__ __forceinline__ void done(const Unit&) const {}
};

__device__ __forceinline__ unsigned cvt_pk_bf16(float lo, float hi) { unsigned r; asm volatile("v_cvt_pk_bf16_f32 %0, %1, %2" : "=v"(r) : "v"(lo), "v"(hi)); return r; }
typedef float f32x2 __attribute__((ext_vector_type(2)));

__device__ __forceinline__ const float* x_src_row(int r, const float* xp, const float* xs, const float* meta) {
    using namespace cfg;
    if (r < FPAD) return nullptr;
    if (r < FPAD + NMETA) return meta + (size_t)(r - FPAD) * DM;
    if (r < MP) return xp + (size_t)(r - FPAD - NMETA) * DM;
    if (r < MPP) return nullptr;
    return xs + (size_t)(r - MPP) * DM;
}
struct EpiF32 {
    static constexpr bool PERM = false, AFTER_DRAIN = false;
    float* O; int ldc;
    __device__ __forceinline__ void operator()(const f32x4 (&acc)[2][2][4][2], const Unit& u, int wr, int wc, int fr, int fq) const {
        const int row0 = u.pm * BM + wr * 64 + fr, col0 = u.pn * BM + wc * 32 + 4 * fq;
#pragma unroll
        for (int ai = 0; ai < 2; ++ai)
#pragma unroll
            for (int m = 0; m < 4; ++m) { float* rowp = O + (size_t)(row0 + ai * HALF + m * 16) * ldc + col0;
#pragma unroll
                for (int bj = 0; bj < 2; ++bj)
#pragma unroll
                    for (int n = 0; n < 2; ++n) *(f32x4*)(rowp + bj * HALF + n * 16) = acc[ai][bj][m][n]; }
    }
};
struct EpiX1 {
    static constexpr bool PERM = false, AFTER_DRAIN = false;
    const float* xp; const float* xs; const float* meta; float* X1; bf16_t* XB; unsigned long long* SSQ; const float* gain;
    __device__ __forceinline__ void operator()(const f32x4 (&acc)[2][2][4][2], const Unit& u, int wr, int wc, int fr, int fq) const {
        const int row0 = u.pm * BM + wr * 64 + fr, col0 = u.pn * BM + wc * 32 + 4 * fq;
        f32x4 gv[2][2];
#pragma unroll
        for (int bj = 0; bj < 2; ++bj)
#pragma unroll
            for (int n = 0; n < 2; ++n) gv[bj][n] = *(const f32x4*)(gain + col0 + bj * HALF + n * 16);
#pragma unroll
        for (int ai = 0; ai < 2; ++ai)
#pragma unroll
            for (int m = 0; m < 4; ++m) { const int r = row0 + ai * HALF + m * 16; const float* src = x_src_row(r, xp, xs, meta); float* rowp = X1 + (size_t)r * cfg::DM + col0; bf16_t* rowb = XB + (size_t)r * cfg::DM + col0;
                float ss = 0.f;
#pragma unroll
                for (int bj = 0; bj < 2; ++bj)
#pragma unroll
                    for (int n = 0; n < 2; ++n) { f32x4 v = (f32x4){0.f, 0.f, 0.f, 0.f}; if (src) v = *(const f32x4*)(src + col0 + bj * HALF + n * 16) + acc[ai][bj][m][n];
                        *(f32x4*)(rowp + bj * HALF + n * 16) = v; ss += (v[0] * v[0] + v[1] * v[1]) + (v[2] * v[2] + v[3] * v[3]);
                        const f32x4 vg = v * gv[bj][n]; f32x2 w; ((unsigned*)&w)[0] = cvt_pk_bf16(vg[0], vg[1]); ((unsigned*)&w)[1] = cvt_pk_bf16(vg[2], vg[3]); *(f32x2*)(rowb + bj * HALF + n * 16) = w; }
                ss += __shfl_xor(ss, 16); ss += __shfl_xor(ss, 32);
                if (fq == 0 && src) (void)__hip_atomic_fetch_add(SSQ + r, (unsigned long long)(ss * 16777216.0f), __ATOMIC_RELAXED, __HIP_MEMORY_SCOPE_AGENT); }
    }
};
struct EpiBfS {
    static constexpr bool PERM = true, AFTER_DRAIN = false;
    bf16_t* O; int ldc; const unsigned long long* SSQ;
    __device__ __forceinline__ void operator()(const f32x4 (&acc)[2][2][4][2], const Unit& u, int wr, int wc, int fr, int fq) const {
        const int row0 = u.pm * BM + wr * 64 + fr, col0 = u.pn * BM + wc * 32 + 8 * fq;
#pragma unroll
        for (int ai = 0; ai < 2; ++ai)
#pragma unroll
            for (int m = 0; m < 4; ++m) { const int r = row0 + ai * HALF + m * 16; bf16_t* rowp = O + (size_t)r * ldc + col0;
                const float rs = 1.0f / sqrtf((float)SSQ[r] * (1.0f / 16777216.0f / 1024.0f) + cfg::NORM_EPS);
#pragma unroll
                for (int bj = 0; bj < 2; ++bj) { const f32x4 v0 = acc[ai][bj][m][0] * rs, v1 = acc[ai][bj][m][1] * rs;
                    u32x4 w; w.x = cvt_pk_bf16(v0[0], v0[1]); w.y = cvt_pk_bf16(v0[2], v0[3]); w.z = cvt_pk_bf16(v1[0], v1[1]); w.w = cvt_pk_bf16(v1[2], v1[3]);
                    *(u32x4*)(rowp + bj * HALF) = w; } }
    }
};
struct EpiConv {
    static constexpr bool PERM = true, AFTER_DRAIN = false;
    bf16_t* Z; bf16_t* ACT; const unsigned long long* SSQ; const float* cw; const float* cb; float* out;
#define PG8_DPPU(oldv, src, ctrl) ((unsigned)__builtin_amdgcn_update_dpp((int)(oldv), (int)(src), (ctrl), 0xF, 0xF, false))
    __device__ __forceinline__ void operator()(const f32x4 (&acc)[2][2][4][2], const Unit& u, int wr, int wc, int fr, int fq) const {
        using namespace cfg;
        const int row0 = u.pm * BM + wr * 64 + fr, f0 = u.pn * 128 + wc * 32 + 8 * fq;
        const bool dectile = u.pm * BM >= MPP;
        unsigned zp[2][2][4][4];
#pragma unroll
        for (int ai = 0; ai < 2; ++ai)
#pragma unroll
            for (int m = 0; m < 4; ++m) { const int r = row0 + ai * HALF + m * 16;
                const float rs = __builtin_amdgcn_rsqf((float)SSQ[r] * (1.0f / 16777216.0f / 1024.0f) + NORM_EPS);
                const bool bnd = dectile ? (fr < 2 || fr >= 14) : ((m == 0 && fr < 2) || (m == 3 && fr >= 14));
                bf16_t* rowp = Z + (size_t)r * NUP + u.pn * BM + wc * 32 + 8 * fq;
                float* cd = nullptr;
                if (fr >= 14) { if (r == MP - 16 + fr) cd = out + O_CP + (size_t)(fr - 14) * NUP; else if (r >= MPP) cd = out + O_CS + ((size_t)((r - MPP) >> 4) * 2 + (fr - 14)) * NUP; }
#pragma unroll
                for (int bj = 0; bj < 2; ++bj) { const f32x4 v0 = acc[ai][bj][m][0] * rs, v1 = acc[ai][bj][m][1] * rs;
                    zp[ai][bj][m][0] = cvt_pk_bf16(v0[0], v0[1]); zp[ai][bj][m][1] = cvt_pk_bf16(v0[2], v0[3]); zp[ai][bj][m][2] = cvt_pk_bf16(v1[0], v1[1]); zp[ai][bj][m][3] = cvt_pk_bf16(v1[2], v1[3]);
                    if (bnd) { u32x4 w; w.x = zp[ai][bj][m][0]; w.y = zp[ai][bj][m][1]; w.z = zp[ai][bj][m][2]; w.w = zp[ai][bj][m][3]; *(u32x4*)(rowp + bj * HALF) = w; }
                    if (cd) { *(f32x4*)(cd + bj * DFF + f0) = v0; *(f32x4*)(cd + bj * DFF + f0 + 4) = v1; } }
            }
        float w[2][3][8], bb[2][8];
#pragma unroll
        for (int bj = 0; bj < 2; ++bj) { const f32x4 b0 = *(const f32x4*)(cb + bj * DFF + f0), b1 = *(const f32x4*)(cb + bj * DFF + f0 + 4);
            bb[bj][0] = b0[0]; bb[bj][1] = b0[1]; bb[bj][2] = b0[2]; bb[bj][3] = b0[3]; bb[bj][4] = b1[0]; bb[bj][5] = b1[1]; bb[bj][6] = b1[2]; bb[bj][7] = b1[3];
#pragma unroll
            for (int j = 0; j < 3; ++j) { const f32x4 w0 = *(const f32x4*)(cw + (size_t)j * NUP + bj * DFF + f0), w1 = *(const f32x4*)(cw + (size_t)j * NUP + bj * DFF + f0 + 4);
                w[bj][j][0] = w0[0]; w[bj][j][1] = w0[1]; w[bj][j][2] = w0[2]; w[bj][j][3] = w0[3]; w[bj][j][4] = w1[0]; w[bj][j][5] = w1[1]; w[bj][j][6] = w1[2]; w[bj][j][7] = w1[3]; } }
#pragma unroll
        for (int ai = 0; ai < 2; ++ai)
#pragma unroll
            for (int m = 0; m < 4; ++m) { const int r = row0 + ai * HALF + m * 16; float cv[2][8];
#pragma unroll
                for (int bj = 0; bj < 2; ++bj)
#pragma unroll
                    for (int p = 0; p < 4; ++p) { const unsigned cur = zp[ai][bj][m][p], prv = zp[ai][bj][m > 0 ? m - 1 : 0][p];
                        const unsigned z1 = PG8_DPPU((unsigned)__builtin_amdgcn_mov_dpp((int)prv, 0x121, 0xF, 0xF, false), cur, 0x111);
                        const unsigned z2 = PG8_DPPU((unsigned)__builtin_amdgcn_mov_dpp((int)prv, 0x122, 0xF, 0xF, false), cur, 0x112);
#pragma unroll
                        for (int h = 0; h < 2; ++h) { const int e = 2 * p + h;
                            const float c0 = __builtin_bit_cast(float, h ? (cur & 0xffff0000u) : (cur << 16)), c1 = __builtin_bit_cast(float, h ? (z1 & 0xffff0000u) : (z1 << 16)), c2 = __builtin_bit_cast(float, h ? (z2 & 0xffff0000u) : (z2 << 16));
                            cv[bj][e] = bb[bj][e] + c2 * w[bj][0][e] + c1 * w[bj][1][e] + c0 * w[bj][2][e]; } }
                float a8[8];
#pragma unroll
                for (int e = 0; e < 8; ++e) { const float g = cv[0][e]; a8[e] = g * __builtin_amdgcn_rcpf(1.0f + __builtin_amdgcn_exp2f(-1.4426950408889634f * g)) * cv[1][e]; }
                u32x4 wo; wo.x = cvt_pk_bf16(a8[0], a8[1]); wo.y = cvt_pk_bf16(a8[2], a8[3]); wo.z = cvt_pk_bf16(a8[4], a8[5]); wo.w = cvt_pk_bf16(a8[6], a8[7]);
                *(u32x4*)(ACT + (size_t)r * DFF + f0) = wo; }
    }
};
struct EpiBf {
    static constexpr bool PERM = true, AFTER_DRAIN = false;
    bf16_t* O; int ldc;
    __device__ __forceinline__ void operator()(const f32x4 (&acc)[2][2][4][2], const Unit& u, int wr, int wc, int fr, int fq) const {
        const int row0 = u.pm * BM + wr * 64 + fr, col0 = u.pn * BM + wc * 32 + 8 * fq;
#pragma unroll
        for (int ai = 0; ai < 2; ++ai)
#pragma unroll
            for (int m = 0; m < 4; ++m) { bf16_t* rowp = O + (size_t)(row0 + ai * HALF + m * 16) * ldc + col0;
#pragma unroll
                for (int bj = 0; bj < 2; ++bj) { const f32x4 v0 = acc[ai][bj][m][0], v1 = acc[ai][bj][m][1];
                    u32x4 w; w.x = cvt_pk_bf16(v0[0], v0[1]); w.y = cvt_pk_bf16(v0[2], v0[3]); w.z = cvt_pk_bf16(v1[0], v1[1]); w.w = cvt_pk_bf16(v1[2], v1[3]);
                    *(u32x4*)(rowp + bj * HALF) = w; } }
    }
};
struct EpiY {
    static constexpr bool PERM = false, AFTER_DRAIN = false;
    const float* X1; float* out;
    __device__ __forceinline__ void operator()(const f32x4 (&acc)[2][2][4][2], const Unit& u, int wr, int wc, int fr, int fq) const {
        using namespace cfg;
        const int row0 = u.pm * BM + wr * 64 + fr, col0 = u.pn * BM + wc * 32 + 4 * fq;
#pragma unroll
        for (int ai = 0; ai < 2; ++ai)
#pragma unroll
            for (int m = 0; m < 4; ++m) { const int r = row0 + ai * HALF + m * 16;
                float* dst = nullptr;
                if (r >= FPAD + NMETA && r < MP) dst = out + O_YP + (size_t)(r - FPAD - NMETA) * DM; else if (r >= MPP) dst = out + O_YS + (size_t)(r - MPP) * DM;
                if (dst) { const float* xr = X1 + (size_t)r * DM + col0;
#pragma unroll
                    for (int bj = 0; bj < 2; ++bj)
#pragma unroll
                        for (int n = 0; n < 2; ++n) *(f32x4*)(dst + col0 + bj * HALF + n * 16) = *(const f32x4*)(xr + bj * HALF + n * 16) + acc[ai][bj][m][n]; } }
    }
};

template <class Epi, class Sched, bool ALIGN_EPI = false, bool SP2 = false>
__device__ __forceinline__ void gemm_phase(PG8_LAS unsigned char* lds, const Gemm g, const Sched& S, const Epi& E) {
    const int tid = threadIdx.x, wid = __builtin_amdgcn_readfirstlane(tid >> 6), lane = tid & 63, wr = wid >> 2, wc = wid & 3, fr = lane & 15, fq = lane >> 4;
    const int K = g.K, nt = K / BK;
    unsigned voffA[2], voffB[2];
#pragma unroll
    for (int i = 0; i < 2; ++i) { int R, C; stage_rc(tid * 16 + i * 8192, R, C); const int Rb = Epi::PERM ? ((R & ~31) + perm32(R & 31)) : R;
        voffA[i] = (unsigned)(R * K + C) * 2u; voffB[i] = (unsigned)(Rb * K + C) * 2u; }
    const size_t kstep = (size_t)(BK * 2);
    const size_t hstep = (size_t)HALF * K * 2;
    const size_t tstep = 2 * hstep;
    const unsigned ldsw = (unsigned)wid * 1024u;
    const int aoff = lds_byte(wr * 64 + fr, fq * 8), boff = lds_byte(wc * 32 + fr, fq * 8);
#define PG8_SA(b, h) (((b) * 2 + (h)) * HTB)
#define PG8_SB(b, h) ((4 + (b) * 2 + (h)) * HTB)
#define PG8_STAGE(bufoff, gbase, voff) do { _Pragma("unroll") for (int _i = 0; _i < 2; ++_i) \
        __builtin_amdgcn_global_load_lds((const unsigned*)((const char*)(gbase) + (voff)[_i]), (PG8_LAS unsigned*)(lds + (bufoff) + ldsw + _i * 8192), 16, 0, 0); } while (0)
#define PG8_LDA(dst, b, h) do { _Pragma("unroll") for (int m = 0; m < 4; ++m) _Pragma("unroll") for (int k = 0; k < 2; ++k) dst[m][k] = *(const PG8_LAS bf16x8*)(lds + PG8_SA(b, h) + aoff + m * 2048 + k * 1024); } while (0)
#define PG8_LDB(dst, b, h) do { _Pragma("unroll") for (int n = 0; n < 2; ++n) _Pragma("unroll") for (int k = 0; k < 2; ++k) dst[n][k] = *(const PG8_LAS bf16x8*)(lds + PG8_SB(b, h) + boff + n * 2048 + k * 1024); } while (0)
#define PG8_MMA(ai, bj, At, Bt) do { __builtin_amdgcn_s_setprio(1); _Pragma("unroll") for (int m = 0; m < 4; ++m) _Pragma("unroll") for (int n = 0; n < 2; ++n) _Pragma("unroll") for (int k = 0; k < 2; ++k) \
        acc[ai][bj][m][n] = __builtin_amdgcn_mfma_f32_16x16x32_bf16(Bt[n][k], At[m][k], acc[ai][bj][m][n], 0, 0, 0); __builtin_amdgcn_s_setprio(0); } while (0)
#define PG8_WAIT_V(n) asm volatile("s_waitcnt vmcnt(" #n ")" ::: "memory")
#define PG8_WAIT_L(n) asm volatile("s_waitcnt lgkmcnt(" #n ")" ::: "memory")
#define PG8_BAR __builtin_amdgcn_s_barrier()
#define PG8_SCHED __builtin_amdgcn_sched_barrier(0)
    Unit cur, nxt; int ui = 0;
    if (!S.next(0, cur)) return;
    f32x4 acc[2][2][4][2];
#pragma unroll
    for (int a = 0; a < 2; ++a)
#pragma unroll
        for (int b = 0; b < 2; ++b)
#pragma unroll
            for (int m = 0; m < 4; ++m)
#pragma unroll
                for (int n = 0; n < 2; ++n) acc[a][b][m][n] = (f32x4){0.f, 0.f, 0.f, 0.f};
    bf16x8 At[4][2], B0[2][2], B1[2][2];
    const char* cA = (const char*)g.A + (size_t)cur.pm * tstep; const char* cB = (const char*)g.Bt + (size_t)cur.pn * tstep;
    S.a_ready(cur);
    if constexpr (SP2) {
        PG8_STAGE(PG8_SB(0, 0), cB, voffB); PG8_STAGE(PG8_SB(0, 1), cB + hstep, voffB); PG8_STAGE(PG8_SA(0, 0), cA, voffA); PG8_STAGE(PG8_SA(0, 1), cA + hstep, voffA);
        if (wr == 1) PG8_BAR;
        PG8_WAIT_V(2); PG8_BAR;
        PG8_STAGE(PG8_SB(1, 0), cB + kstep, voffB); PG8_STAGE(PG8_SA(1, 0), cA + kstep, voffA); PG8_STAGE(PG8_SB(1, 1), cB + hstep + kstep, voffB);
        PG8_WAIT_V(6); PG8_BAR;
    } else {
        PG8_STAGE(PG8_SB(0, 0), cB, voffB); PG8_STAGE(PG8_SA(0, 0), cA, voffA); PG8_STAGE(PG8_SB(0, 1), cB + hstep, voffB); PG8_STAGE(PG8_SA(0, 1), cA + hstep, voffA);
        if (wr == 1) PG8_BAR;
        PG8_WAIT_V(4); PG8_BAR;
        PG8_STAGE(PG8_SB(1, 0), cB + kstep, voffB); PG8_STAGE(PG8_SA(1, 0), cA + kstep, voffA); PG8_STAGE(PG8_SB(1, 1), cB + hstep + kstep, voffB);
        PG8_WAIT_V(6); PG8_BAR;
    }
    for (;;) {
        const bool has_next = S.next(ui + 1, nxt);
        const char* nA = has_next ? (const char*)g.A + (size_t)nxt.pm * tstep : cA; const char* nB = has_next ? (const char*)g.Bt + (size_t)nxt.pn * tstep : cB;
        for (int t = 0; t < nt; t += 2) {
            const bool last = (t == nt - 2);
            const char* a1 = cA + (size_t)(t + 1) * kstep;
            const char* a2 = last ? nA : cA + (size_t)(t + 2) * kstep; const char* b2 = last ? nB : cB + (size_t)(t + 2) * kstep;
            const char* a3 = a2 + kstep; const char* b3 = b2 + kstep;
            if (last && has_next) S.a_ready(nxt);
            if constexpr (SP2) {
            PG8_LDB(B0, 0, 0); PG8_LDB(B1, 0, 1); PG8_SCHED; PG8_LDA(At, 0, 0); PG8_STAGE(PG8_SA(1, 1), a1 + hstep, voffA);
            PG8_WAIT_V(8); PG8_WAIT_L(0); PG8_BAR; PG8_MMA(0, 0, At, B0); PG8_MMA(0, 1, At, B1); PG8_BAR; PG8_SCHED;
            PG8_LDA(At, 0, 1); PG8_STAGE(PG8_SB(0, 0), b2, voffB); PG8_STAGE(PG8_SB(0, 1), b2 + hstep, voffB); PG8_STAGE(PG8_SA(0, 0), a2, voffA);
            PG8_WAIT_V(8); PG8_WAIT_L(0); PG8_BAR; PG8_MMA(1, 0, At, B0); PG8_MMA(1, 1, At, B1); PG8_BAR; PG8_SCHED;
            PG8_LDB(B0, 1, 0); PG8_LDB(B1, 1, 1); PG8_SCHED; PG8_LDA(At, 1, 0); PG8_STAGE(PG8_SA(0, 1), a2 + hstep, voffA);
            PG8_WAIT_V(8); PG8_WAIT_L(0); PG8_BAR; PG8_MMA(0, 0, At, B0); PG8_MMA(0, 1, At, B1); PG8_BAR; PG8_SCHED;
            PG8_LDA(At, 1, 1); PG8_STAGE(PG8_SB(1, 0), b3, voffB); PG8_STAGE(PG8_SB(1, 1), b3 + hstep, voffB); PG8_STAGE(PG8_SA(1, 0), a3, voffA);
            PG8_WAIT_V(8); PG8_WAIT_L(0); PG8_BAR; PG8_MMA(1, 0, At, B0); PG8_MMA(1, 1, At, B1); PG8_BAR; PG8_SCHED;
            } else {
            PG8_LDB(B0, 0, 0); PG8_SCHED; PG8_LDA(At, 0, 0); PG8_STAGE(PG8_SA(1, 1), a1 + hstep, voffA);
            PG8_WAIT_L(8); PG8_BAR; PG8_WAIT_L(0); PG8_MMA(0, 0, At, B0); PG8_BAR; PG8_SCHED;
            PG8_LDB(B1, 0, 1); PG8_STAGE(PG8_SB(0, 0), b2, voffB);
            PG8_BAR; PG8_WAIT_L(0); PG8_MMA(0, 1, At, B1); PG8_BAR;
            PG8_LDA(At, 0, 1); PG8_STAGE(PG8_SA(0, 0), a2, voffA);
            PG8_BAR; PG8_WAIT_L(0); PG8_MMA(1, 0, At, B0); PG8_BAR; PG8_SCHED;
            PG8_STAGE(PG8_SB(0, 1), b2 + hstep, voffB);
            PG8_WAIT_V(6); PG8_BAR; PG8_MMA(1, 1, At, B1); PG8_BAR;
            PG8_LDB(B0, 1, 0); PG8_SCHED; PG8_LDA(At, 1, 0); PG8_STAGE(PG8_SA(0, 1), a2 + hstep, voffA);
            PG8_WAIT_L(8); PG8_BAR; PG8_WAIT_L(0); PG8_MMA(0, 0, At, B0); PG8_BAR; PG8_SCHED;
            PG8_LDB(B1, 1, 1); PG8_STAGE(PG8_SB(1, 0), b3, voffB);
            PG8_BAR; PG8_WAIT_L(0); PG8_MMA(0, 1, At, B1); PG8_BAR;
            PG8_LDA(At, 1, 1); PG8_STAGE(PG8_SA(1, 0), a3, voffA);
            PG8_BAR; PG8_WAIT_L(0); PG8_MMA(1, 0, At, B0); PG8_BAR; PG8_SCHED;
            PG8_STAGE(PG8_SB(1, 1), b3 + hstep, voffB);
            PG8_WAIT_V(6); PG8_BAR; PG8_MMA(1, 1, At, B1); PG8_BAR;
            }
        }
        if constexpr (ALIGN_EPI) { if (wr == 0) PG8_BAR; }
        if constexpr (!Epi::AFTER_DRAIN) { E(acc, cur, wr, wc, fr, fq); S.done(cur); }
        if (!has_next) break;
#pragma unroll
        for (int a = 0; a < 2; ++a)
#pragma unroll
            for (int b = 0; b < 2; ++b)
#pragma unroll
                for (int m = 0; m < 4; ++m)
#pragma unroll
                    for (int n = 0; n < 2; ++n) acc[a][b][m][n] = (f32x4){0.f, 0.f, 0.f, 0.f};
        cur = nxt; cA = nA; cB = nB; ++ui;
        if constexpr (ALIGN_EPI) { if (wr == 1) PG8_BAR; }
    }
    PG8_WAIT_V(0);
    if constexpr (!ALIGN_EPI) { if (wr == 0) PG8_BAR; }
    PG8_BAR;
    if constexpr (Epi::AFTER_DRAIN) { E.fused(acc, cur, wr, wc, fr, fq, lds, wid, lane); S.done(cur); }
#undef PG8_SA
#undef PG8_SB
#undef PG8_STAGE
#undef PG8_LDA
#undef PG8_LDB
#undef PG8_MMA
#undef PG8_WAIT_V
#undef PG8_WAIT_L
#undef PG8_BAR
#undef PG8_SCHED
}
}
#define GAS __attribute__((address_space(1)))
#define LAS __attribute__((address_space(3)))
typedef unsigned short bf16;
typedef unsigned v4u __attribute__((ext_vector_type(4)));
typedef float f32x4 __attribute__((ext_vector_type(4)));
typedef short bf16x8 __attribute__((ext_vector_type(8)));
typedef GAS unsigned gu32;
typedef GAS unsigned long long gu64;
#define RLX_AGENT __ATOMIC_RELAXED, __HIP_MEMORY_SCOPE_AGENT
#define LDS_WAIT() asm volatile("s_waitcnt lgkmcnt(0)" ::: "memory")
#define VM_WAIT() asm volatile("s_waitcnt vmcnt(0)" ::: "memory")
__device__ __forceinline__ unsigned long long rt() { return __builtin_amdgcn_s_memrealtime(); }
__device__ __forceinline__ unsigned f2bf(float f) { unsigned u = __builtin_bit_cast(unsigned, f); return (u + 0x7fffu + ((u >> 16) & 1u)) >> 16; }
typedef float f32x2_t __attribute__((ext_vector_type(2))); typedef __bf16 bf16x2_t __attribute__((ext_vector_type(2)));
__device__ __forceinline__ unsigned pk2(float lo, float hi) { f32x2_t v = {lo, hi}; bf16x2_t b = __builtin_convertvector(v, bf16x2_t); return __builtin_bit_cast(unsigned, b); }

#define XB_TMO      128
#define XB_XCNT(j)  (256  + 64 * (j))
#define XB_XSUB(j)  (1280 + 64 * (j))
#define XB_XGEN(j)  (2304 + 64 * (j))
#define XB_TOP      3328
#define XB_TOPGEN   3392
#define XCD_BAR_WORDS 3456
#define XB_SPIN_CAP (1u << 18)

__device__ __forceinline__ unsigned xb_ld(unsigned* p)              { return __hip_atomic_load(p, __ATOMIC_RELAXED, __HIP_MEMORY_SCOPE_AGENT); }
__device__ __forceinline__ unsigned xb_add(unsigned* p, unsigned v) { return __hip_atomic_fetch_add(p, v, __ATOMIC_RELAXED, __HIP_MEMORY_SCOPE_AGENT); }
__device__ __forceinline__ unsigned xb_xcc_id() { return (unsigned)__builtin_amdgcn_s_getreg((3 << 11) | 20) & 0xFu; }
#define XB_SPIN(cond, bar) do { unsigned _sp = 0; while (cond) { __builtin_amdgcn_s_sleep(1); \
    if ((++_sp & 255u) == 0u) { if (xb_ld(&(bar)[XB_TMO])) break; if (_sp > XB_SPIN_CAP) { atomicAdd(&(bar)[XB_TMO], 1u); break; } } } } while (0)

struct XcdBarrier {
    unsigned* bar; unsigned x;
    volatile LAS unsigned* st;
};

__device__ __forceinline__ XcdBarrier xcd_barrier_post(unsigned* bar, volatile LAS unsigned* st) {
    XcdBarrier b; b.bar = bar; b.x = xb_xcc_id(); b.st = st;
    if (threadIdx.x == 0) (void)xb_add(&bar[XB_XCNT(b.x)], 1u);
    return b;
}
__device__ __forceinline__ void xcd_barrier_complete(unsigned* bar, unsigned x, unsigned& nloc, unsigned& nx) {
    const unsigned G = gridDim.x * gridDim.y * gridDim.z;
    unsigned sum, cnt, mine, sp = 0u;
    for (;;) {
        sum = 0u; cnt = 0u; mine = 0u;
#pragma unroll
        for (unsigned j = 0; j < 16; ++j) { const unsigned c = xb_ld(&bar[XB_XCNT(j)]); sum += c; cnt += (c > 0u) ? 1u : 0u; mine = (j == x) ? c : mine; }
        if (sum == G) break;
        __builtin_amdgcn_s_sleep(1);
        if ((++sp & 255u) == 0u) { if (xb_ld(&bar[XB_TMO])) break; if (sp > XB_SPIN_CAP) { atomicAdd(&bar[XB_TMO], 1u); break; } }
    }
    nloc = mine > 0u ? mine : 1u; nx = cnt > 0u ? cnt : 1u;
}

__device__ __forceinline__ void xcd_barrier(const XcdBarrier& b) {
    asm volatile("s_waitcnt vmcnt(0)" ::: "memory");
    __syncthreads();
    if (threadIdx.x == 0) {
        unsigned* bar = b.bar;
        __builtin_amdgcn_s_waitcnt(0);
        unsigned nloc = b.st[0], nx = b.st[1];
        if (nloc == 0u) { xcd_barrier_complete(bar, b.x, nloc, nx); b.st[0] = nloc; b.st[1] = nx; }
        const unsigned old = xb_add(&bar[XB_XSUB(b.x)], 1u);
        const unsigned gen = old / nloc;
        if (old + 1u == (gen + 1u) * nloc) {
            __builtin_amdgcn_fence(__ATOMIC_RELEASE, "agent");
            asm volatile("s_waitcnt vmcnt(0)" ::: "memory");
            const unsigned og = xb_add(&bar[XB_TOP], 1u);
            const unsigned tg = og / nx;
            if (og + 1u == (tg + 1u) * nx) xb_add(&bar[XB_TOPGEN], 1u);
            else XB_SPIN(xb_ld(&bar[XB_TOPGEN]) == tg, bar);
            __builtin_amdgcn_fence(__ATOMIC_ACQUIRE, "agent");
            xb_add(&bar[XB_XGEN(b.x)], 1u);
            asm volatile("s_waitcnt vmcnt(0)" ::: "memory");
        } else {
            XB_SPIN(xb_ld(&bar[XB_XGEN(b.x)]) == gen, bar);
            __builtin_amdgcn_fence(__ATOMIC_ACQUIRE, "agent");
            asm volatile("s_waitcnt vmcnt(0)" ::: "memory");
        }
    }
    __syncthreads();
}
constexpr size_t MiB = 1u << 20;
constexpr size_t WS_CTL = 0, CTL_ZERO_BYTES = 1 * MiB, WS_SSQ_OFF = 512 * 1024;
constexpr size_t WS_WIN = 2 * MiB, WS_WOUT = 9 * MiB, WS_WUP = 11 * MiB, WS_WDN = 22 * MiB, WS_WLT = 28 * MiB;
constexpr size_t WS_XN = 32 * MiB, WS_QB = 66 * MiB, WS_KB = 83 * MiB, WS_VB = 100 * MiB, WS_MIX = 117 * MiB, WS_X1 = 151 * MiB;
constexpr size_t WS_PROJ = 218 * MiB, WS_Z = WS_PROJ, WS_LW = 436 * MiB, WS_LIN = 564 * MiB;
constexpr size_t WS_RW = 436 * MiB, RW_STRIDE = (size_t)cfg::M * 512 * 4, WS_ACT = WS_RW;
constexpr size_t WS_SC = 671 * MiB, SC_STRIDE = (size_t)cfg::M * 8 * 4;
constexpr size_t WS_VX = 600 * MiB;
constexpr size_t WS_YI = 673 * MiB, WS_QC = 707 * MiB, WS_PC = 740 * MiB, WS_GC = 773 * MiB, WS_S0 = 806 * MiB, WS_DPART = 839 * MiB, WS_DML = 871 * MiB, WS_END = 872 * MiB;
static_assert(WS_WIN + (size_t)3328 * 1024 * 2 <= WS_WOUT && WS_WUP + (size_t)5632 * 1024 * 2 <= WS_WDN && WS_WDN + (size_t)1024 * 2816 * 2 <= WS_WLT, "ws weights");
static_assert(WS_XN + (size_t)cfg::M * 1024 * 2 <= WS_QB && WS_QB + (size_t)cfg::M * 512 * 2 <= WS_KB && WS_VB + (size_t)cfg::M * 512 * 2 <= WS_MIX && WS_MIX + (size_t)cfg::M * 1024 * 2 <= WS_X1, "ws act");
static_assert(WS_X1 + (size_t)cfg::M * 1024 * 4 <= WS_PROJ && WS_PROJ + (size_t)cfg::M * 3328 * 4 <= WS_RW && WS_Z + (size_t)cfg::M * 5632 * 2 <= WS_RW, "ws proj");
static_assert(WS_LW + (size_t)cfg::M * 1536 * 2 <= WS_LIN && WS_LIN + (size_t)cfg::M * 256 * 2 <= WS_VX && WS_VX + RW_STRIDE <= WS_SC && WS_SC + 3 * SC_STRIDE <= WS_YI && WS_YI + RW_STRIDE <= WS_QC && WS_QC + (size_t)8 * 257 * 4096 * 4 <= WS_PC, "ws rw");
static_assert(WS_PC + (size_t)8 * 257 * 4096 * 4 <= WS_GC && WS_GC + (size_t)8 * 257 * 4096 * 4 <= WS_S0 && WS_S0 + (size_t)8 * 257 * 4096 * 4 <= WS_DPART && WS_DPART + (size_t)256 * 8 * 2 * 2048 * 4 <= WS_DML, "ws rw2");
constexpr int CW_BAR = 4096;
constexpr int CW_QATT = 64, CW_QDEC = 128;
constexpr int CW_QH = 2048;
constexpr int CW_R2DONE = 192, CW_DECDONE = 320;

constexpr int RING_OFF = 0, RING_BYTES = 131072;
constexpr int LDSCTL_OFF = RING_BYTES, MISC_OFF = LDSCTL_OFF + 320;
constexpr float ATT_THR = 6.0f;
constexpr int ATT_TB_OFF = MISC_OFF + 256;
constexpr int LDS_BYTES = 147456;
constexpr int NWAVES = 8;
constexpr int N_LAUNCHES = MK_N_LAUNCHES;
constexpr int N_PHASES = 13;

typedef float f32x16 __attribute__((ext_vector_type(16)));
typedef short s16x4 __attribute__((ext_vector_type(4)));
typedef short v4i16_t __attribute__((ext_vector_type(4)));

struct Args { const float* in[35]; float* out; unsigned char* ws; int ph_lo, ph_hi, li, pad; };
enum { I_XP = 0, I_XS, I_CK, I_CV, I_SRW, I_SSH, I_SCV, I_META, I_RELB, I_LN1, I_WIN, I_QNG, I_KNG, I_LQ1, I_LK1, I_LQ2, I_LK2, I_SUBLN, I_MU, I_W0, I_W2, I_A0, I_A2, I_G2,
       I_KK, I_KA, I_RK, I_LNXW, I_LNXB, I_WOUT, I_LN2, I_WUP, I_CONVW, I_CONVB, I_WDN };

__device__ __forceinline__ float wave_sum(float v) {
#pragma unroll
    for (int o = 1; o < 64; o <<= 1) v += __shfl_xor(v, o);
    return v;
}
__device__ __forceinline__ float quad_sum(float x) {
    x += __int_as_float(__builtin_amdgcn_mov_dpp(__float_as_int(x), 0xB1, 0xF, 0xF, true));
    x += __int_as_float(__builtin_amdgcn_mov_dpp(__float_as_int(x), 0x4E, 0xF, 0xF, true));
    return x;
}
__device__ __forceinline__ float sum16(float x) {
    x += __shfl_xor(x, 1); x += __shfl_xor(x, 2); x += __shfl_xor(x, 4); x += __shfl_xor(x, 8); return x;
}
__device__ __forceinline__ bf16x8 pack8(float a0, float a1, float a2, float a3, float a4, float a5, float a6, float a7) {
    v4u w; w.x = pk2(a0, a1); w.y = pk2(a2, a3); w.z = pk2(a4, a5); w.w = pk2(a6, a7); return __builtin_bit_cast(bf16x8, w);
}
__device__ __forceinline__ float ex2(float x) { return __builtin_amdgcn_exp2f(x); }
__device__ __forceinline__ float fexp(float x) { return __builtin_amdgcn_exp2f(x * 1.4426950408889634f); }
__device__ __forceinline__ float flog(float x) { return __builtin_amdgcn_logf(x) * 0.6931471805599453f; }
__device__ __forceinline__ float sigm(float x) { return __builtin_amdgcn_rcpf(1.0f + fexp(-x)); }
__device__ __forceinline__ float ftanh(float x) { return 1.0f - 2.0f * __builtin_amdgcn_rcpf(fexp(2.0f * x) + 1.0f); }
#define MFMA16(a, b, c) __builtin_amdgcn_mfma_f32_16x16x32_bf16((a), (b), (c), 0, 0, 0)
#define MFMA32(a, b, c) __builtin_amdgcn_mfma_f32_32x32x16_bf16((a), (b), (c), 0, 0, 0)
#define MFMA4F(a, b, c) __builtin_amdgcn_mfma_f32_16x16x4f32((a), (b), (c), 0, 0, 0)

__device__ __forceinline__ void p0_transpose_item(const float* W, int K, int N, bf16* WT, int row_off, LAS float* scr, int item, int lane, const float* kscale = nullptr) {
    const int nblk = N / 32, kb = item / nblk, nb = item % nblk, k0 = 64 * kb, n0 = 32 * nb;
#pragma unroll 8
    for (int i = 0; i < 32; ++i) { const int kk = 2 * i + (lane >> 5); float w = W[(size_t)(k0 + kk) * N + n0 + (lane & 31)]; if (kscale) w *= kscale[k0 + kk]; scr[kk * 33 + (lane & 31)] = w; }
    LDS_WAIT(); asm volatile("" ::: "memory");
    const int c = lane & 7;
#pragma unroll
    for (int j = 0; j < 4; ++j) { const int n = (lane >> 3) + 8 * j; const LAS float* s = scr + (8 * c) * 33 + n;
        v4u o; o.x = pk2(s[0 * 33], s[1 * 33]); o.y = pk2(s[2 * 33], s[3 * 33]); o.z = pk2(s[4 * 33], s[5 * 33]); o.w = pk2(s[6 * 33], s[7 * 33]);
        *(GAS v4u*)(WT + (size_t)(row_off + n0 + n) * K + k0 + 8 * c) = o; }
    LDS_WAIT(); asm volatile("" ::: "memory");
}
__device__ __forceinline__ void rms_row_bf16(const float* src, const float* gain, bf16* dst, int lane) {
    GAS unsigned long long* o8 = (GAS unsigned long long*)dst + lane;
    if (!src) {
#pragma unroll
        for (int j = 0; j < 4; ++j) o8[64 * j] = 0ull;
        return;
    }
    const GAS f32x4* xr = (const GAS f32x4*)src + lane; const GAS f32x4* gr = (const GAS f32x4*)gain + lane;
    f32x4 v[4]; float s = 0.f;
#pragma unroll
    for (int j = 0; j < 4; ++j) { v[j] = xr[64 * j]; s += (v[j].x * v[j].x + v[j].y * v[j].y) + (v[j].z * v[j].z + v[j].w * v[j].w); }
    const float rs = 1.0f / sqrtf(wave_sum(s) * (1.0f / 1024.0f) + cfg::NORM_EPS);
#pragma unroll
    for (int j = 0; j < 4; ++j) { const f32x4 g = gr[64 * j];
        o8[64 * j] = (unsigned long long)pk2(v[j].x * rs * g.x, v[j].y * rs * g.y) | ((unsigned long long)pk2(v[j].z * rs * g.z, v[j].w * rs * g.w) << 32); }
}
__device__ __forceinline__ void late_weights(const Args& a, LAS unsigned char* lds, int pw, int NPW, int wave, int lane) {
    LAS float* scr = (LAS float*)(lds + wave * 16384);
    unsigned char* ws = a.ws;
    constexpr int N_OUT = 16 * 32, N_UP = 16 * 176, N_DN = 44 * 32;
    for (int it = pw; it < N_OUT + N_UP + N_DN; it += NPW) {
        int r = it;
        if (r < N_OUT) { p0_transpose_item(a.in[I_WOUT], 1024, 1024, (bf16*)(ws + WS_WOUT), 0, scr, r, lane); continue; } r -= N_OUT;
        if (r < N_UP) { const int n0 = 32 * (r % 176), hf = n0 >= 2816, cc = n0 - hf * 2816;
            p0_transpose_item(a.in[I_WUP], 1024, 5632, (bf16*)(ws + WS_WUP), 256 * (cc >> 7) + 128 * hf + (cc & 127) - n0, scr, r, lane); continue; } r -= N_UP;
        p0_transpose_item(a.in[I_WDN], 2816, 1024, (bf16*)(ws + WS_WDN), 0, scr, r, lane);
    }
}
__device__ __forceinline__ void ph_prologue(const Args& a, LAS unsigned char* lds, int gw, int NGW, int wave, int lane) {
    using namespace cfg;
    LAS float* scr = (LAS float*)(lds + wave * 16384);
    unsigned char* ws = a.ws;
    constexpr int N_IN = 16 * 104;
    for (int it = gw; it < N_IN; it += NGW) p0_transpose_item(a.in[I_WIN], 1024, 3328, (bf16*)(ws + WS_WIN), 0, scr, it, lane);
    {
        bf16* WLT = (bf16*)(ws + WS_WLT);
        for (int it = gw * 64 + lane; it < 1536 * 32; it += NGW * 64) { const int n = it >> 5, k0 = (it & 31) * 8, sect = n >> 9, c = n & 511; float v[8];
#pragma unroll
            for (int i = 0; i < 8; ++i) { const int k = k0 + i; v[i] = sect == 0 ? (k < 64 ? a.in[I_W2][k * 512 + c] : 0.f) : sect == 1 ? ((k >= 64 && k < 128) ? a.in[I_A2][(k - 64) * 512 + c] : 0.f) : (k >= 128 ? a.in[I_G2][(k - 128) * 512 + c] : 0.f); }
            v4u w; w.x = pk2(v[0], v[1]); w.y = pk2(v[2], v[3]); w.z = pk2(v[4], v[5]); w.w = pk2(v[6], v[7]); *(v4u*)(WLT + (size_t)n * 256 + k0) = w; }
    }
    bf16* XN = (bf16*)(ws + WS_XN);
    for (int m = gw; m < M; m += NGW) rms_row_bf16(pg8::x_src_row(m, a.in[I_XP], a.in[I_XS], a.in[I_META]), a.in[I_LN1], XN + (size_t)m * DM, lane);
}

__device__ __forceinline__ void unpack8(v4u w, float* f) {
    f[0] = __uint_as_float(w.x << 16); f[1] = __uint_as_float(w.x & 0xffff0000u); f[2] = __uint_as_float(w.y << 16); f[3] = __uint_as_float(w.y & 0xffff0000u);
    f[4] = __uint_as_float(w.z << 16); f[5] = __uint_as_float(w.z & 0xffff0000u); f[6] = __uint_as_float(w.w << 16); f[7] = __uint_as_float(w.w & 0xffff0000u);
}
__device__ __forceinline__ void ph_rowpass(const Args& a, int gw, int NGW, int lane) {
    using namespace cfg;
    const bf16* PROJ = (const bf16*)(a.ws + WS_PROJ);
    bf16* Qb = (bf16*)(a.ws + WS_QB); bf16* Kb = (bf16*)(a.ws + WS_KB); bf16* Vb = (bf16*)(a.ws + WS_VB); bf16* LIN = (bf16*)(a.ws + WS_LIN);
    float qg[8], kg[8];
#pragma unroll
    for (int i = 0; i < 8; ++i) { qg[i] = a.in[I_QNG][8 * (lane & 7) + i] * QSCALE; kg[i] = a.in[I_KNG][8 * (lane & 7) + i]; }
    for (int m = gw; m < M; m += NGW) {
        const bf16* p = PROJ + (size_t)m * NPROJ + 8 * lane;
        const v4u qw = *(const v4u*)p, kw = *(const v4u*)(p + 512), vw = *(const v4u*)(p + 1024);
        float q[8], k[8], v[8]; unpack8(qw, q); unpack8(kw, k); unpack8(vw, v);
        float sq = 0.f, sk = 0.f;
#pragma unroll
        for (int i = 0; i < 8; ++i) { sq += q[i] * q[i]; sk += k[i] * k[i]; }
        sq += __shfl_xor(sq, 1); sq += __shfl_xor(sq, 2); sq += __shfl_xor(sq, 4);
        sk += __shfl_xor(sk, 1); sk += __shfl_xor(sk, 2); sk += __shfl_xor(sk, 4);
        const float rq = 1.0f / sqrtf(sq * (1.0f / 64.0f) + NORM_EPS), rk = 1.0f / sqrtf(sk * (1.0f / 64.0f) + NORM_EPS);
        v4u w;
        w.x = pk2(q[0] * rq * qg[0], q[1] * rq * qg[1]); w.y = pk2(q[2] * rq * qg[2], q[3] * rq * qg[3]); w.z = pk2(q[4] * rq * qg[4], q[5] * rq * qg[5]); w.w = pk2(q[6] * rq * qg[6], q[7] * rq * qg[7]);
        *(v4u*)(Qb + (size_t)m * 512 + 8 * lane) = w;
#pragma unroll
        for (int i = 0; i < 8; ++i) k[i] = k[i] * rk * kg[i];
        w.x = pk2(k[0], k[1]); w.y = pk2(k[2], k[3]); w.z = pk2(k[4], k[5]); w.w = pk2(k[6], k[7]);
        *(v4u*)(Kb + (size_t)m * 512 + 8 * lane) = w;
        *(v4u*)(Vb + (size_t)m * 512 + 8 * lane) = vw;
        float* kdst = nullptr; float* vdst = nullptr; float* sdst = nullptr;
        if (m >= FPAD && m < MP) { kdst = a.out + O_KP + (size_t)(m - FPAD) * 512; vdst = a.out + O_VP + (size_t)(m - FPAD) * 512; }
        else if (m >= MPP) { kdst = a.out + O_KS + (size_t)(m - MPP) * 512; vdst = a.out + O_VS + (size_t)(m - MPP) * 512; }
        if (kdst) { *(f32x4*)(kdst + 8 * lane) = (f32x4){k[0], k[1], k[2], k[3]}; *(f32x4*)(kdst + 8 * lane + 4) = (f32x4){k[4], k[5], k[6], k[7]};
                    *(f32x4*)(vdst + 8 * lane) = (f32x4){v[0], v[1], v[2], v[3]}; *(f32x4*)(vdst + 8 * lane + 4) = (f32x4){v[4], v[5], v[6], v[7]}; }
        if (m == MP - 1) sdst = a.out + O_HP; else if (m >= MPP && ((m - MPP) & 15) == 15) sdst = a.out + O_HS + (size_t)((m - MPP) >> 4) * NPR;
        if (sdst) { const bf16* pr = PROJ + (size_t)m * NPROJ + PR0; for (int c = lane; c < NPR; c += 64) sdst[c] = __uint_as_float((unsigned)pr[c] << 16); }
        if (lane < 32) {
            const int c = 8 * lane, sect = c >> 6;
            float x[8], pv[8]; unpack8(*(const v4u*)(PROJ + (size_t)m * NPROJ + PR0 + 1536 + c), x);
            const bool dec0 = m >= MPP && ((m - MPP) & 15) == 0;
            if (dec0) { const float* sh = a.in[I_SSH] + (size_t)((m - MPP) >> 4) * NPR + 1536 + c; const f32x4 s0 = *(const f32x4*)sh, s1 = *(const f32x4*)(sh + 4); pv[0] = s0.x; pv[1] = s0.y; pv[2] = s0.z; pv[3] = s0.w; pv[4] = s1.x; pv[5] = s1.y; pv[6] = s1.z; pv[7] = s1.w; }
            else if (m == 0) {
#pragma unroll
                for (int i = 0; i < 8; ++i) pv[i] = 0.f; }
            else unpack8(*(const v4u*)(PROJ + (size_t)(m - 1) * NPROJ + PR0 + 1536 + c), pv);
            const float* mu = a.in[I_MU] + 1536 + c;
#pragma unroll
            for (int i = 0; i < 8; ++i) { float xm = x[i] + (pv[i] - x[i]) * mu[i]; xm = sect == 0 ? ftanh(xm) : sect == 1 ? xm : sigm(xm); x[i] = xm; }
            w.x = pk2(x[0], x[1]); w.y = pk2(x[2], x[3]); w.z = pk2(x[4], x[5]); w.w = pk2(x[6], x[7]);
            *(v4u*)(LIN + (size_t)m * 256 + c) = w;
        }
    }
}

typedef float f32x2 __attribute__((ext_vector_type(2)));
__device__ __forceinline__ float fma_s(float a, float b, float c) { float d; asm("v_fma_f32 %0, %1, %2, %3" : "=v"(d) : "v"(a), "v"(b), "v"(c)); return d; }
__device__ __forceinline__ float fma_v(float a, float b, float c) { float d; asm volatile("v_fma_f32 %0, %1, %2, %3" : "=v"(d) : "v"(a), "v"(b), "v"(c)); return d; }
__device__ __forceinline__ float mul_s(float a, float b) { float d; asm("v_mul_f32_e32 %0, %1, %2" : "=v"(d) : "v"(a), "v"(b)); return d; }
__device__ __forceinline__ float row16_sum(float x) {
    x += __int_as_float(__builtin_amdgcn_mov_dpp(__float_as_int(x), 0xB1, 0xF, 0xF, true));
    x += __int_as_float(__builtin_amdgcn_mov_dpp(__float_as_int(x), 0x4E, 0xF, 0xF, true));
    x += __int_as_float(__builtin_amdgcn_mov_dpp(__float_as_int(x), 0x141, 0xF, 0xF, true));
    x += __int_as_float(__builtin_amdgcn_mov_dpp(__float_as_int(x), 0x140, 0xF, 0xF, true));
    return x;
}
__device__ __forceinline__ f32x4 unpack4(unsigned lo, unsigned hi) { return (f32x4){__uint_as_float(lo << 16), __uint_as_float(lo & 0xffff0000u), __uint_as_float(hi << 16), __uint_as_float(hi & 0xffff0000u)}; }
constexpr int R1_LWB = 2 * (49152 + 512) + 8192, R1_CAR = R1_LWB + 8192;
constexpr int R1_BUF = 49152 + 512, R1_CST = 2 * R1_BUF;
struct R1Unit { int kind, h, cb, row0, nsub; };
__device__ __forceinline__ void r1_run(const Args& a, LAS unsigned char* lds, const R1Unit u, int tid, int wave, int lane) {
    using namespace cfg;
    asm volatile("" : "+v"(lane), "+v"(tid));
    const bf16* PROJ = (const bf16*)(a.ws + WS_PROJ); const bf16* LW = (const bf16*)(a.ws + WS_LW);
    float* YI = (float*)(a.ws + WS_YI); float* QC = (float*)(a.ws + WS_QC); float* PC = (float*)(a.ws + WS_PC); float* GC = (float*)(a.ws + WS_GC); float* RKR = (float*)(a.ws + WS_SC); float* VX = (float*)(a.ws + WS_VX);
    const int p = wave >> 1, role = wave & 1, q = lane & 3, rg = lane >> 2;
    const int ss = (tid >> 4) & 7, ch4 = (tid & 15) * 4, cc = u.h * 64 + ch4;
    { LAS float* cst = (LAS float*)(lds + R1_CST) + p * 512; const int x = tid & 127;
#pragma unroll
      for (int i = 0; i < 4; ++i) { const int e = x + 128 * i, arr = e >> 6, ch = e & 63; const int gc = u.h * 64 + ch;
          const float v = arr == 0 ? a.in[I_MU][gc] : arr == 1 ? a.in[I_MU][512 + gc] : arr == 2 ? a.in[I_MU][1024 + gc] : arr == 3 ? a.in[I_W0][gc] : arr == 4 ? a.in[I_A0][gc] : arr == 5 ? a.in[I_KK][gc] : arr == 6 ? a.in[I_KA][gc] : a.in[I_RK][gc];
          cst[e] = v; }
      if (x < 64) ((LAS float*)(lds + R1_CAR))[p * 64 + x] = 0.f; }
    f32x2 S[4][8];
#pragma unroll
    for (int ii = 0; ii < 2; ++ii) {
        if (u.kind == 2) { const float* sp = a.in[I_SRW] + ((size_t)(u.cb * 8 + u.h) * 64 + rg + 16 * ii + 32 * role) * 64 + 16 * q;
#pragma unroll
            for (int j4 = 0; j4 < 4; ++j4) { const f32x4 v = *(const f32x4*)(sp + 4 * j4); S[ii][2 * j4] = (f32x2){v.x, v.y}; S[ii][2 * j4 + 1] = (f32x2){v.z, v.w}; } }
        else {
#pragma unroll
            for (int j2 = 0; j2 < 8; ++j2) S[ii][j2] = (f32x2){0.f, 0.f}; }
    }
    { int rgv = rg; asm volatile("" : "+v"(rgv));
#pragma unroll
      for (int ii = 2; ii < 4; ++ii)
#pragma unroll
          for (int j2 = 0; j2 < 8; ++j2) S[ii][j2] = (f32x2){(q == ii - 2 + 2 * role && rgv == 2 * j2) ? 1.0f : 0.0f, (q == ii - 2 + 2 * role && rgv == 2 * j2 + 1) ? 1.0f : 0.0f}; }
    const bool ystore = !(u.kind == 2 && q >= 2);
    float* yout = q < 2 ? YI + (size_t)u.row0 * 512 + u.h * 64 + rg + 16 * q + 32 * role : GC + (size_t)(u.h * NCH + u.cb) * 4096 + (size_t)(u.row0 & 63) * 64 + rg + 16 * (q - 2) + 32 * role;
    const int ystride = q < 2 ? 512 : 64;
    unsigned sr[8][2];
#define R1_LOAD(sc) do { const unsigned row_ = (unsigned)(u.row0 + 8 * (sc) + ss); const bf16* pp_ = PROJ + (size_t)row_ * NPROJ + PR0 + cc; \
        _Pragma("unroll") for (int x_ = 0; x_ < 3; ++x_) { const unsigned long long c_ = *(const unsigned long long*)(pp_ + 512 * x_), d_ = *(const unsigned long long*)(pp_ - NPROJ + 512 * x_); \
            sr[x_][0] = (unsigned)c_; sr[x_][1] = (unsigned)(c_ >> 32); sr[3 + x_][0] = (unsigned)d_; sr[3 + x_][1] = (unsigned)(d_ >> 32); } \
        { const unsigned long long c_ = *(const unsigned long long*)(LW + (size_t)row_ * 1536 + cc), d_ = *(const unsigned long long*)(LW + (size_t)row_ * 1536 + 512 + cc); sr[6][0] = (unsigned)c_; sr[6][1] = (unsigned)(c_ >> 32); sr[7][0] = (unsigned)d_; sr[7][1] = (unsigned)(d_ >> 32); } } while (0)
#define R1_STAGE(sc, buf) do { const unsigned row_ = (unsigned)(u.row0 + 8 * (sc) + ss); \
        const LAS float* cs_ = (const LAS float*)(lds + R1_CST) + p * 512 + ch4; \
        f32x4 xr_ = unpack4(sr[0][0], sr[0][1]), xk_ = unpack4(sr[1][0], sr[1][1]), xv_ = unpack4(sr[2][0], sr[2][1]); \
        f32x4 pr_ = unpack4(sr[3][0], sr[3][1]), pk_ = unpack4(sr[4][0], sr[4][1]), pv_ = unpack4(sr[5][0], sr[5][1]); \
        if (u.kind == 2 && (sc) == 0 && ss == 0) { const float* sh_ = a.in[I_SSH] + (size_t)u.cb * NPR + cc; pr_ = *(const f32x4*)sh_; pk_ = *(const f32x4*)(sh_ + 512); pv_ = *(const f32x4*)(sh_ + 1024); } \
        const f32x4 r_ = xr_ + (pr_ - xr_) * *(const LAS f32x4*)(cs_), k_ = xk_ + (pk_ - xk_) * *(const LAS f32x4*)(cs_ + 64), v_ = xv_ + (pv_ - xv_) * *(const LAS f32x4*)(cs_ + 128); \
        __builtin_amdgcn_sched_barrier(0); \
        const f32x4 w0_ = *(const LAS f32x4*)(cs_ + 192), a0_ = *(const LAS f32x4*)(cs_ + 256), kkc_ = *(const LAS f32x4*)(cs_ + 320), kac_ = *(const LAS f32x4*)(cs_ + 384), rkc_ = *(const LAS f32x4*)(cs_ + 448); \
        const f32x4 slw0_ = unpack4(sr[6][0], sr[6][1]), slw1_ = unpack4(sr[7][0], sr[7][1]); f32x4 al_, dec_, kkr_ = k_ * kkc_; \
        _Pragma("unroll") for (int e_ = 0; e_ < 4; ++e_) { al_[e_] = sigm(a0_[e_] + slw1_[e_]); const float xw_ = w0_[e_] + slw0_[e_]; \
            const float sp_ = fmaxf(-xw_, 0.f) + flog(1.0f + fexp(-fabsf(xw_))); dec_[e_] = -fexp(-sp_ - 0.5f); }        \
        __builtin_amdgcn_sched_barrier(0); \
          \
        { LAS float* lwb_ = (LAS float*)(lds + R1_LWB) + (p * 8 + ss) * 64 + ch4; *(LAS f32x4*)lwb_ = dec_; } \
        __syncthreads(); \
        f32x4 Lt_ = *(const LAS f32x4*)((const LAS float*)(lds + R1_CAR) + (((sc) & 1) * 4 + p) * 64 + ch4); \
        _Pragma("unroll") for (int s_ = 0; s_ < 8; ++s_) { const f32x4 x_ = *(const LAS f32x4*)((const LAS float*)(lds + R1_LWB) + (p * 8 + s_) * 64 + ch4); if (s_ <= ss) Lt_ += x_; } \
        if (ss == 7) *(LAS f32x4*)((LAS float*)(lds + R1_CAR) + ((((sc) + 1) & 1) * 4 + p) * 64 + ch4) = Lt_; \
        __builtin_amdgcn_sched_barrier(0); \
        f32x4 ea_, eb_, er_; \
        _Pragma("unroll") for (int e_ = 0; e_ < 4; ++e_) { ea_[e_] = fexp(Lt_[e_] - dec_[e_]); eb_[e_] = fexp(-Lt_[e_]); er_[e_] = fexp(Lt_[e_]); } \
        __builtin_amdgcn_sched_barrier(0); \
        const float inv_ = 1.0f / fmaxf(sqrtf(row16_sum((kkr_.x * kkr_.x + kkr_.y * kkr_.y) + (kkr_.z * kkr_.z + kkr_.w * kkr_.w))), 1e-12f); \
        const f32x4 kk_ = kkr_ * inv_, kp_ = k_ * (1.0f + (al_ - 1.0f) * kac_), bb_ = kk_ * al_; \
        const f32x4 t1_ = bb_ * r_, t2_ = kp_ * r_, t3_ = t2_ * rkc_; \
        const float br_ = row16_sum((t1_.x + t1_.y) + (t1_.z + t1_.w)), kr_ = row16_sum((t2_.x + t2_.y) + (t2_.z + t2_.w)), rkr_ = row16_sum((t3_.x + t3_.y) + (t3_.z + t3_.w)); \
        LAS float* vb_ = (LAS float*)(lds + (buf) * R1_BUF + (p * 8 + ss) * 1536) + ch4; \
          \
        *(LAS f32x4*)(vb_) = -kk_ * ea_; *(LAS f32x4*)(vb_ + 128) = r_ * er_; *(LAS f32x4*)(vb_ + 192) = bb_ * eb_; *(LAS f32x4*)(vb_ + 256) = kp_ * eb_; *(LAS f32x4*)(vb_ + 320) = v_; \
        *(f32x4*)(VX + (size_t)row_ * 512 + cc) = v_; \
        if ((tid & 15) == 0) { LAS float* sc_ = (LAS float*)(lds + (buf) * R1_BUF + 49152) + (p * 8 + ss) * 2; sc_[0] = br_; sc_[1] = kr_; RKR[(size_t)row_ * 8 + u.h] = rkr_; } } while (0)
    R1_LOAD(0);
    __syncthreads();
    R1_STAGE(0, 0);
    __syncthreads();
    for (int sc = 0; sc < u.nsub; ++sc) {
        const bool more = sc + 1 < u.nsub;
        if (more) R1_LOAD(sc + 1);
        {
            const LAS unsigned char* bb = lds + (sc & 1) * R1_BUF;
#define R1_STEP(VAL) do { \
                const LAS float* vb = (const LAS float*)(bb + (p * 8 + s) * 1536) + 16 * q; \
                f32x4 xb[4], xk[4];                                      \
                _Pragma("unroll") for (int j4 = 0; j4 < 4; ++j4) { xb[j4] = *(const LAS f32x4*)(vb + 192 + 4 * j4); if (VAL) xk[j4] = *(const LAS f32x4*)(vb + 256 + 4 * j4); } \
                float vv[4] = {0.f, 0.f, 0.f, 0.f}; \
                _Pragma("unroll") for (int ii = 0; ii < 2; ++ii) vv[ii] = ((const LAS float*)(bb + (p * 8 + s) * 1536))[320 + rg + 16 * ii + 32 * role]; \
                const LAS float* scl = (const LAS float*)(bb + 49152) + (p * 8 + s) * 2; \
                const float brs = scl[0], krs = scl[1]; \
                float ys[4], d1a[4], d1b[4], d2a[4], d2b[4], dd1[4];     \
                _Pragma("unroll") for (int ii = 0; ii < 4; ++ii) { d1a[ii] = 0.f; d1b[ii] = 0.f; d2a[ii] = 0.f; d2b[ii] = 0.f; }     \
                _Pragma("unroll") for (int j2 = 0; j2 < 8; ++j2) \
                    _Pragma("unroll") for (int ii = 0; ii < 4; ++ii) { const float sx = S[ii][j2].x, sy = S[ii][j2].y; \
                        d1a[ii] = fma_v(sx, xa[j2 >> 1][2 * (j2 & 1)], d1a[ii]); d1b[ii] = fma_v(sy, xa[j2 >> 1][2 * (j2 & 1) + 1], d1b[ii]); \
                        d2a[ii] = fma_v(sx, xwr[j2 >> 1][2 * (j2 & 1)], d2a[ii]); d2b[ii] = fma_v(sy, xwr[j2 >> 1][2 * (j2 & 1) + 1], d2b[ii]); } \
                asm volatile("" ::: "memory");                           \
                if (s < 7) { const LAS float* vn = vb + 384;               \
                    _Pragma("unroll") for (int j4 = 0; j4 < 4; ++j4) { xa[j4] = *(const LAS f32x4*)(vn + 4 * j4); xwr[j4] = *(const LAS f32x4*)(vn + 128 + 4 * j4); } } \
                _Pragma("unroll") for (int ii = 0; ii < 4; ++ii) { \
                    const float d1 = quad_sum(d1a[ii] + d1b[ii]), d2 = quad_sum(d2a[ii] + d2b[ii]); dd1[ii] = d1; \
                    ys[ii] = ii < 2 ? d2 + d1 * brs + vv[ii] * krs : d2 + d1 * brs; } \
                _Pragma("unroll") for (int j2 = 0; j2 < 8; ++j2) { float sx[4], sy[4];     \
                    _Pragma("unroll") for (int ii = 0; ii < 4; ++ii) { sx[ii] = fma_v(xb[j2 >> 1][2 * (j2 & 1)], dd1[ii], S[ii][j2].x); sy[ii] = fma_v(xb[j2 >> 1][2 * (j2 & 1) + 1], dd1[ii], S[ii][j2].y); } \
                    _Pragma("unroll") for (int ii = 0; ii < 2; ++ii) { sx[ii] = fma_v(xk[j2 >> 1][2 * (j2 & 1)], vv[ii], sx[ii]); sy[ii] = fma_v(xk[j2 >> 1][2 * (j2 & 1) + 1], vv[ii], sy[ii]); } \
                    _Pragma("unroll") for (int ii = 0; ii < 4; ++ii) S[ii][j2] = (f32x2){sx[ii], sy[ii]}; } \
                const float ysel = q == 0 ? ys[0] : q == 1 ? ys[1] : q == 2 ? ys[2] : ys[3]; \
                if (ystore) yout[(size_t)(8 * sc + s) * ystride] = ysel; } while (0)
            f32x4 xa[4], xwr[4];
            { const LAS float* v0 = (const LAS float*)(bb + (p * 8) * 1536) + 16 * q;
#pragma unroll
              for (int j4 = 0; j4 < 4; ++j4) { xa[j4] = *(const LAS f32x4*)(v0 + 4 * j4); xwr[j4] = *(const LAS f32x4*)(v0 + 128 + 4 * j4); } }
#pragma unroll 1
            for (int s = 0; s < 8; ++s) R1_STEP(true);
#undef R1_STEP
        }
        if (more) R1_STAGE(sc + 1, (sc + 1) & 1);
        __syncthreads();
    }
#undef R1_LOAD
#undef R1_STAGE
    {
        { const LAS float* car = (const LAS float*)(lds + R1_CAR) + ((u.nsub & 1) * 4 + p) * 64 + 16 * q;
#pragma unroll
          for (int j4 = 0; j4 < 4; ++j4) { const f32x4 L4 = *(const LAS f32x4*)(car + 4 * j4); const float g0 = fexp(L4.x), g1 = fexp(L4.y), g2 = fexp(L4.z), g3 = fexp(L4.w);
#pragma unroll
              for (int ii = 0; ii < 4; ++ii) { S[ii][2 * j4].x *= g0; S[ii][2 * j4].y *= g1; S[ii][2 * j4 + 1].x *= g2; S[ii][2 * j4 + 1].y *= g3; } } }
        float* qout = u.kind == 2 ? a.out + O_SS + (size_t)(u.cb * 8 + u.h) * 4096 : QC + (size_t)(u.h * NCH + u.cb) * 4096;
        float* pout = PC + (size_t)(u.h * NCH + u.cb) * 4096;
#pragma unroll
        for (int ii = 0; ii < 4; ++ii) {
            if (ii >= 2 && u.kind == 2) continue;
            float* sp = (ii < 2 ? qout : pout) + (size_t)(rg + 16 * (ii & 1) + 32 * role) * 64 + 16 * q;
#pragma unroll
            for (int j4 = 0; j4 < 4; ++j4) *(f32x4*)(sp + 4 * j4) = (f32x4){S[ii][2 * j4].x, S[ii][2 * j4].y, S[ii][2 * j4 + 1].x, S[ii][2 * j4 + 1].y};
        }
    }
}
__device__ __forceinline__ void ph_r1(const Args& a, LAS unsigned char* lds, int bx, int G, int tid, int wave, int lane) {
    using namespace cfg;
    const int p = wave >> 1;
    for (int quad = bx; quad < 512 + 66; quad += G) {
        R1Unit u;
        if (quad < 512) { const int U = quad * 4 + p; u.kind = 0; u.h = U & 7; u.cb = 1 + (U >> 3); u.row0 = 64 * u.cb; u.nsub = 8; }
        else { const int su = (quad - 512) * 4 + p; u.nsub = 2;
            if (su < 8) { u.kind = 1; u.h = su; u.cb = 0; u.row0 = FPAD; } else { const int d = su - 8; u.kind = 2; u.h = d & 7; u.cb = d >> 3; u.row0 = MPP + 16 * u.cb; } }
        r1_run(a, lds, u, tid, wave, lane);
    }
}

__device__ __forceinline__ void ph_r2(const Args& a, LAS unsigned char* lds, int unit, int wave, int lane, gu32* done_cnt) {
    using namespace cfg;
    const float* QC = (const float*)(a.ws + WS_QC); const float* PC = (const float*)(a.ws + WS_PC); float* S0T = (float*)(a.ws + WS_S0);
    const int h = unit >> 2, rb = unit & 3, n = lane & 15, g = lane >> 4, i = 16 * rb + n;
    LAS float* st = (LAS float*)lds;
    for (int x = threadIdx.x; x < 2048; x += 512) st[x] = 0.f;
    __syncthreads();
    f32x4 mine = (f32x4){0.f, 0.f, 0.f, 0.f};
    float pa[16]; f32x4 q4 = (f32x4){0.f, 0.f, 0.f, 0.f};
    if (wave < 4) {
        const float* pc = PC + (size_t)(h * NCH) * 4096 + 16 * wave + n;
#pragma unroll
        for (int kk = 0; kk < 16; ++kk) pa[kk] = pc[(16 * (kk >> 2) + 4 * g + (kk & 3)) * 64];
        q4 = *(const f32x4*)(QC + (size_t)(h * NCH) * 4096 + (size_t)i * 64 + 16 * wave + 4 * g);
    }
    for (int c = 0; c < NCH; ++c) {
        const int cur = c & 1;
        if (wave < 4) {
            float* s0 = S0T + (size_t)(h * NCH + c) * 4096 + (size_t)(16 * wave + 4 * g) * 64 + i;
#pragma unroll
            for (int reg = 0; reg < 4; ++reg) s0[reg * 64] = mine[reg];
            float pn[16]; f32x4 qn = (f32x4){0.f, 0.f, 0.f, 0.f};
            if (c + 1 < NCH) {
                const float* pc = PC + (size_t)(h * NCH + c + 1) * 4096 + 16 * wave + n;
#pragma unroll
                for (int kk = 0; kk < 16; ++kk) pn[kk] = pc[(16 * (kk >> 2) + 4 * g + (kk & 3)) * 64];
                qn = *(const f32x4*)(QC + (size_t)(h * NCH + c + 1) * 4096 + (size_t)i * 64 + 16 * wave + 4 * g);
            } else {
#pragma unroll
                for (int kk = 0; kk < 16; ++kk) pn[kk] = 0.f;
            }
            float bvv[16];
#pragma unroll
            for (int kk = 0; kk < 16; ++kk) bvv[kk] = st[cur * 1024 + (16 * (kk >> 2) + 4 * g + (kk & 3)) * 16 + n];
            f32x4 acc0 = q4, acc1 = (f32x4){0.f, 0.f, 0.f, 0.f};
#pragma unroll
            for (int kk = 0; kk < 16; kk += 2) { acc0 = MFMA4F(pa[kk], bvv[kk], acc0); acc1 = MFMA4F(pa[kk + 1], bvv[kk + 1], acc1); }
            mine = acc0 + acc1;
#pragma unroll
            for (int reg = 0; reg < 4; ++reg) st[(cur ^ 1) * 1024 + (16 * wave + 4 * g + reg) * 16 + n] = mine[reg];
#pragma unroll
            for (int kk = 0; kk < 16; ++kk) pa[kk] = pn[kk];
            q4 = qn;
        }
        __syncthreads();
    }
    if (wave < 4) *(f32x4*)(a.out + O_SP + (size_t)(h * 64 + i) * 64 + 16 * wave + 4 * g) = mine;
    asm volatile("s_waitcnt vmcnt(0)" ::: "memory"); __syncthreads();
    if (threadIdx.x == 0) { __builtin_amdgcn_fence(__ATOMIC_RELEASE, "agent"); asm volatile("s_waitcnt vmcnt(0)" ::: "memory"); (void)__hip_atomic_fetch_add(done_cnt, 1u, __ATOMIC_RELAXED, __HIP_MEMORY_SCOPE_AGENT); }
}

__device__ __forceinline__ void glds16(const void* gsrc, unsigned lds_dst) {
    unsigned keep;
    asm volatile("s_mov_b32 %0, m0\n\ts_mov_b32 m0, %2\n\ts_nop 0\n\tglobal_load_lds_dwordx4 %1, off\n\ts_mov_b32 m0, %0" : "=&s"(keep) : "v"(gsrc), "s"(lds_dst) : "memory");
}
__device__ __forceinline__ void glds16s(const void* sbase, unsigned voff, unsigned lds_dst) {
    unsigned keep;
    asm volatile("s_mov_b32 %0, m0\n\ts_mov_b32 m0, %3\n\ts_nop 0\n\tglobal_load_lds_dwordx4 %1, %2\n\ts_mov_b32 m0, %0" : "=&s"(keep) : "v"(voff), "s"(sbase), "s"(lds_dst) : "memory");
}
__device__ __forceinline__ void dec_attn_unit(const Args& a, LAS unsigned char* lds, const LAS float* tb, int unit, int wave, int lane) {
    using namespace cfg;
    asm volatile("" : "+v"(lane));
    const int b = unit >> 3, h = (unit >> 1) & 3, half = unit & 1, n = lane & 15, g = lane >> 4;
    const bf16* Qb = (const bf16*)(a.ws + WS_QB);
    bf16x8 qf[2][2];
#pragma unroll
    for (int c = 0; c < 2; ++c)
#pragma unroll
        for (int ks = 0; ks < 2; ++ks) qf[c][ks] = *(const bf16x8*)(Qb + (size_t)(MPP + b * 16 + n) * 512 + h * 128 + c * 64 + 32 * ks + 8 * g);
    float mr[2] = {-1e30f, -1e30f}, lr[2] = {0.f, 0.f};
    f32x4 o[2][8];
#pragma unroll
    for (int c = 0; c < 2; ++c)
#pragma unroll
        for (int et = 0; et < 8; ++et) o[c][et] = (f32x4){0.f, 0.f, 0.f, 0.f};
    const int send = half ? 129 : 64;
    f32x4 kx[2][2][2][2];
#define DEC_KLOAD(s_) do { _Pragma("unroll") for (int kt2 = 0; kt2 < 2; ++kt2) { const int kt16 = 2 * (s_) + kt2; \
        const float* kp = (kt16 < 257 ? a.in[I_CK] + ((size_t)b * NCK + 16 * kt16 + n) * 512 : a.out + O_KS + ((size_t)b * 16 + n) * 512) + h * 128 + 8 * g; \
        _Pragma("unroll") for (int c = 0; c < 2; ++c) _Pragma("unroll") for (int ks = 0; ks < 2; ++ks) { kx[kt2][c][ks][0] = *(const f32x4*)(kp + c * 64 + 32 * ks); kx[kt2][c][ks][1] = *(const f32x4*)(kp + c * 64 + 32 * ks + 4); } } } while (0)
    LAS unsigned char* vb = lds + wave * 16384; const unsigned vb0 = (unsigned)(uintptr_t)vb;
    const unsigned voA = (unsigned)((lane >> 5) * 2048 + 16 * (lane & 31)), voB = (unsigned)((lane >> 5) * 2048 + 16 * ((lane & 31) ^ 4));
#define DEC_VDMA(s_) do { const char* cb_ = (const char*)(a.in[I_CV] + ((size_t)b * NCK + 32 * (s_)) * 512 + h * 128);     \
        const char* ob_ = (s_) == 128 ? (const char*)(a.out + O_VS + (size_t)b * 16 * 512 + h * 128) - 8 * 4096 : cb_;     \
        _Pragma("unroll") for (int i_ = 0; i_ < 16; ++i_) { const char* vp_ = (i_ >= 8 ? ob_ : cb_) + i_ * 4096; \
        unsigned keep_; asm volatile("s_mov_b32 %0, m0\n\ts_mov_b32 m0, %3\n\ts_nop 0\n\tglobal_load_lds_dwordx4 %1, %2\n\ts_mov_b32 m0, %0" : "=&s"(keep_) : "v"(((i_ >> 1) & 1) ? voB : voA), "s"(vp_), "s"((unsigned)__builtin_amdgcn_readfirstlane(vb0 + i_ * 1024)) : "memory"); } } while (0)
    if (64 * half + wave < send) { DEC_KLOAD(64 * half + wave); DEC_VDMA(64 * half + wave); }
    for (int s = 64 * half + wave; s < send; s += 8) {
        f32x4 sa[2][2];
#pragma unroll
        for (int kt2 = 0; kt2 < 2; ++kt2)
#pragma unroll
            for (int c = 0; c < 2; ++c) {
                f32x4 acc = (f32x4){0.f, 0.f, 0.f, 0.f};
#pragma unroll
                for (int ks = 0; ks < 2; ++ks) { const f32x4 x0 = kx[kt2][c][ks][0], x1 = kx[kt2][c][ks][1];
                    acc = MFMA16(pack8(x0.x, x0.y, x0.z, x0.w, x1.x, x1.y, x1.z, x1.w), qf[c][ks], acc); }
                sa[c][kt2] = acc;
            }
        if (s >= 120) {
#pragma unroll
            for (int kt2 = 0; kt2 < 2; ++kt2)
#pragma unroll
                for (int reg = 0; reg < 4; ++reg) { int idx = 16 * (2 * s + kt2) + 4 * g + reg - (NCK + n) + 191; idx = idx < 0 ? 0 : idx; const float bias = tb[idx];
                    sa[0][kt2][reg] += bias; sa[1][kt2][reg] += bias; }
        }
        bf16x8 pa[2];
#pragma unroll
        for (int c = 0; c < 2; ++c) {
            float mx = fmaxf(fmaxf(fmaxf(sa[c][0][0], sa[c][0][1]), fmaxf(sa[c][0][2], sa[c][0][3])), fmaxf(fmaxf(sa[c][1][0], sa[c][1][1]), fmaxf(sa[c][1][2], sa[c][1][3])));
            mx = fmaxf(mx, __shfl_xor(mx, 16)); mx = fmaxf(mx, __shfl_xor(mx, 32));
            const float mn = fmaxf(mr[c], mx), al = ex2(mr[c] - mn); mr[c] = mn;
            float p[8], ls = 0.f;
#pragma unroll
            for (int e = 0; e < 8; ++e) { p[e] = ex2(sa[c][e >> 2][e & 3] - mn); ls += p[e]; }
            lr[c] = lr[c] * al + ls;
            float alq[4];
#pragma unroll
            for (int reg = 0; reg < 4; ++reg) alq[reg] = __shfl(al, 4 * g + reg);
#pragma unroll
            for (int et = 0; et < 8; ++et) { o[c][et][0] *= alq[0]; o[c][et][1] *= alq[1]; o[c][et][2] *= alq[2]; o[c][et][3] *= alq[3]; }
            pa[c] = pack8(p[0], p[1], p[2], p[3], p[4], p[5], p[6], p[7]);
        }
        asm volatile("s_waitcnt vmcnt(0)" ::: "memory");
        { const LAS unsigned char* vl = vb + (4 * g) * 512 + (n >> 2) * 16 + (n & 3) * 4;
#pragma unroll
          for (int et = 0; et < 8; ++et) { const LAS unsigned char* ve = vl + 64 * (et ^ (g & 1)); float x[8];
#pragma unroll
              for (int j = 0; j < 8; ++j) x[j] = *(const LAS float*)(ve + (16 * (j >> 2) + (j & 3)) * 512);
              const bf16x8 vf = pack8(x[0], x[1], x[2], x[3], x[4], x[5], x[6], x[7]);
              o[0][et] = MFMA16(pa[0], vf, o[0][et]); o[1][et] = MFMA16(pa[1], vf, o[1][et]); } }
        if (s + 8 < send) { asm volatile("s_waitcnt lgkmcnt(0)" ::: "memory"); DEC_VDMA(s + 8); DEC_KLOAD(s + 8); }
    }
    asm volatile("s_waitcnt vmcnt(0)" ::: "memory");
#undef DEC_KLOAD
#undef DEC_VDMA
    float* part = (float*)(a.ws + WS_DPART) + (size_t)(unit * 8 + wave) * 2 * 2048; float* ml = (float*)(a.ws + WS_DML) + (size_t)(unit * 8 + wave) * 2 * 32;
#pragma unroll
    for (int c = 0; c < 2; ++c) {
        float l = lr[c]; l += __shfl_xor(l, 16); l += __shfl_xor(l, 32);
        if (g == 0) { ml[c * 32 + 2 * n] = mr[c]; ml[c * 32 + 2 * n + 1] = l; }
#pragma unroll
        for (int et = 0; et < 8; ++et)
#pragma unroll
            for (int reg = 0; reg < 4; ++reg) part[c * 2048 + (4 * g + reg) * 128 + 16 * et + n] = o[c][et][reg];
    }
}
__device__ __forceinline__ void build_bias_table(LAS float* tb, const float* relb, int h, int tid) {
    if (tid < 256) {
        const int rel = tid - 191, nn = rel < 0 ? -rel : rel;
        int bk = nn < 8 ? nn : nn < 12 ? 8 : nn < 16 ? 9 : nn < 23 ? 10 : nn < 32 ? 11 : nn < 46 ? 12 : nn < 64 ? 13 : nn < 91 ? 14 : 15;
        if (rel > 0) bk += 16;
        tb[tid] = (relb[bk * 4 + h] - relb[15 * 4 + h]) * 1.4426950408889634f;
    }
}
__device__ __forceinline__ void r3_unit(const Args& a, int tl, int h, int lane) {
    using namespace cfg;
    asm volatile("" : "+v"(lane));
    const float* GC = (const float*)(a.ws + WS_GC); const float* S0T = (const float*)(a.ws + WS_S0); const float* YI = (const float*)(a.ws + WS_YI);
    const float* VX = (const float*)(a.ws + WS_VX); const bf16* LW = (const bf16*)(a.ws + WS_LW); const float* RKR = (const float*)(a.ws + WS_SC);
    bf16* MIX = (bf16*)(a.ws + WS_MIX);
    const int n = lane & 15, g = lane >> 4;
    const int row0 = tl < NCH ? 64 * tl : MPP + 64 * (tl - NCH);
        f32x4 acc[4][4];
#pragma unroll
        for (int mt = 0; mt < 4; ++mt)
#pragma unroll
            for (int nt = 0; nt < 4; ++nt) acc[mt][nt] = (f32x4){0.f, 0.f, 0.f, 0.f};
        if (tl > 0 && tl < NCH) {
            const float* gp = GC + (size_t)(h * NCH + tl) * 4096 + n * 64 + 8 * g;
            const float* sp = S0T + (size_t)(h * NCH + tl) * 4096 + (8 * g) * 64 + n;
            bf16x8 af[2][4], bfr[2][4];
#pragma unroll
            for (int ks = 0; ks < 2; ++ks) {
#pragma unroll
                for (int mt = 0; mt < 4; ++mt) { const f32x4 x0 = *(const f32x4*)(gp + (size_t)mt * 1024 + 32 * ks), x1 = *(const f32x4*)(gp + (size_t)mt * 1024 + 32 * ks + 4); af[ks][mt] = pack8(x0.x, x0.y, x0.z, x0.w, x1.x, x1.y, x1.z, x1.w); }
#pragma unroll
                for (int nt = 0; nt < 4; ++nt) { float b8[8];
#pragma unroll
                    for (int e = 0; e < 8; ++e) b8[e] = sp[(size_t)(32 * ks + e) * 64 + 16 * nt];
                    bfr[ks][nt] = pack8(b8[0], b8[1], b8[2], b8[3], b8[4], b8[5], b8[6], b8[7]); } }
#pragma unroll
            for (int ks = 0; ks < 2; ++ks)
#pragma unroll
                for (int mt = 0; mt < 4; ++mt)
#pragma unroll
                    for (int nt = 0; nt < 4; ++nt) acc[mt][nt] = MFMA16(af[ks][mt], bfr[ks][nt], acc[mt][nt]);
        }
        float lw[4], lb[4];
#pragma unroll
        for (int nt = 0; nt < 4; ++nt) { lw[nt] = a.in[I_LNXW][h * 64 + 16 * nt + n]; lb[nt] = a.in[I_LNXB][h * 64 + 16 * nt + n]; }
#pragma unroll
        for (int mt = 0; mt < 4; ++mt) {
            float yi[4][4], vx[4][4], gg[4][4], rk[4];
#pragma unroll
            for (int reg = 0; reg < 4; ++reg) { const unsigned row = (unsigned)(row0 + 16 * mt + 4 * g + reg), ib = row * 512u + (unsigned)(h * 64 + n);
                rk[reg] = RKR[row * 8u + (unsigned)h];
#pragma unroll
                for (int nt = 0; nt < 4; ++nt) { yi[reg][nt] = YI[ib + 16 * nt]; vx[reg][nt] = VX[ib + 16 * nt]; gg[reg][nt] = __uint_as_float((unsigned)LW[row * 1536u + 1024u + (unsigned)(h * 64 + 16 * nt + n)] << 16); } }
#pragma unroll
            for (int reg = 0; reg < 4; ++reg) {
                const unsigned row = (unsigned)(row0 + 16 * mt + 4 * g + reg);
                float y[4], s = 0.f;
#pragma unroll
                for (int nt = 0; nt < 4; ++nt) { y[nt] = acc[mt][nt][reg] + yi[reg][nt]; s += y[nt]; }
                const float mean = row16_sum(s) * (1.0f / 64.0f); float v2 = 0.f;
#pragma unroll
                for (int nt = 0; nt < 4; ++nt) { y[nt] -= mean; v2 += y[nt] * y[nt]; }
                const float rstd = 1.0f / sqrtf(row16_sum(v2) * (1.0f / 64.0f) + GN_EPS);
#pragma unroll
                for (int nt = 0; nt < 4; ++nt) { const float ov = (y[nt] * rstd * lw[nt] + lb[nt] + rk[reg] * vx[reg][nt]) * gg[reg][nt];
                    MIX[(size_t)row * 1024 + 512 + h * 64 + 16 * nt + n] = (bf16)(pk2(ov, 0.f) & 0xffffu); }
            }
        }
}
__device__ __forceinline__ void decfin_row(const Args& a, int rid, int lane, float lam) {
    using namespace cfg;
    asm volatile("" : "+v"(lane));
    bf16* MIX = (bf16*)(a.ws + WS_MIX);
    const float* part = (const float*)(a.ws + WS_DPART); const float* ml = (const float*)(a.ws + WS_DML);
    {
        const int b = rid >> 6, h = (rid >> 4) & 3, q = rid & 15;
        const int p = lane & 15, c = (lane >> 4) & 1;
        const size_t pi = (size_t)(((b * 4 + h) * 2 + (p >> 3)) * 8 + (p & 7));
        const float mp = ml[pi * 64 + c * 32 + 2 * q], lp = ml[pi * 64 + c * 32 + 2 * q + 1];
        float pv[2][16][2];
#pragma unroll
        for (int cc = 0; cc < 2; ++cc)
#pragma unroll
            for (int pp = 0; pp < 16; ++pp) { const size_t pj = (size_t)(((b * 4 + h) * 2 + (pp >> 3)) * 8 + (pp & 7)) * 4096 + cc * 2048 + q * 128; pv[cc][pp][0] = part[pj + lane]; pv[cc][pp][1] = part[pj + 64 + lane]; }
        float mm = mp; mm = fmaxf(mm, __shfl_xor(mm, 1)); mm = fmaxf(mm, __shfl_xor(mm, 2)); mm = fmaxf(mm, __shfl_xor(mm, 4)); mm = fmaxf(mm, __shfl_xor(mm, 8));
        const float wgt = ex2(mp - mm); float L = lp * wgt; L += __shfl_xor(L, 1); L += __shfl_xor(L, 2); L += __shfl_xor(L, 4); L += __shfl_xor(L, 8);
        const float wn = wgt / L;
        float oc[2][2];
#pragma unroll
        for (int cc = 0; cc < 2; ++cc) { float o0 = 0.f, o1 = 0.f;
#pragma unroll
            for (int pp = 0; pp < 16; ++pp) { const float w_ = __shfl(wn, pp + 16 * cc); o0 += pv[cc][pp][0] * w_; o1 += pv[cc][pp][1] * w_; }
            oc[cc][0] = o0; oc[cc][1] = o1; }
        const float d0 = oc[0][0] - lam * oc[1][0], d1 = oc[0][1] - lam * oc[1][1];
        const float rstd = 1.0f / sqrtf(wave_sum(d0 * d0 + d1 * d1) * (1.0f / 128.0f) + NORM_EPS);
        bf16* dst = MIX + (size_t)(MPP + b * 16 + q) * 1024 + h * 128;
        dst[lane] = (bf16)(pk2(d0 * rstd * a.in[I_SUBLN][lane] * (1.0f - LAM_INIT), 0.f) & 0xffffu); dst[64 + lane] = (bf16)(pk2(d1 * rstd * a.in[I_SUBLN][64 + lane] * (1.0f - LAM_INIT), 0.f) & 0xffffu);
    }
}
__device__ __forceinline__ void ph_r3(const Args& a, int gw, int NGW, int lane, float lam, int mode = 3) {
    using namespace cfg;
    if (mode & 1) for (int u = gw; u < NT64 * 8; u += NGW) { const int h = u & 7, tl = u < 2048 ? 1 + (u >> 3) : (u < 2056 ? 0 : NCH + ((u - 2056) >> 3)); r3_unit(a, tl, h, lane); }
    if (mode & 2) for (int rid = gw; rid < DB * 4 * 16; rid += NGW) decfin_row(a, rid, lane, lam);
}

__device__ __forceinline__ int crow(int r, int hi) { return (r & 3) + 8 * (r >> 2) + 4 * hi; }
__device__ __forceinline__ s16x4 vtr(const LAS unsigned char* p) { return __builtin_bit_cast(s16x4, __builtin_amdgcn_ds_read_tr16_b64_v4i16((LAS v4i16_t*)p)); }
__device__ __forceinline__ void attn_unit(const Args& a, LAS unsigned char* lds, int h, int qt, float lam, int tid, int wave, int lane) {
    using namespace cfg;
    asm volatile("" : "+v"(lane), "+v"(tid));
    const bf16* Qb = (const bf16*)(a.ws + WS_QB); const bf16* Kb = (const bf16*)(a.ws + WS_KB); const bf16* Vb = (const bf16*)(a.ws + WS_VB); bf16* MIX = (bf16*)(a.ws + WS_MIX);
    LAS float* tb = (LAS float*)(lds + ATT_TB_OFF); LAS float* scr = (LAS float*)(lds + ATT_TB_OFF + 1024 + wave * 128);
    const int comp = wave >> 2, qg = wave & 3, r = lane & 31, hh = lane >> 5;
    const int ntile = 2 * qt + 2, my_nt = qg < 2 ? ntile - 1 : ntile, q0 = 128 * qt + 32 * qg;
    build_bias_table(tb, a.in[I_RELB], h, tid);
    bf16x8 qr[4];
#pragma unroll
    for (int d0 = 0; d0 < 4; ++d0) qr[d0] = *(const bf16x8*)(Qb + (size_t)(q0 + r) * 512 + h * 128 + comp * 64 + 16 * d0 + 8 * hh);
    f32x16 o[4];
#pragma unroll
    for (int eb = 0; eb < 4; ++eb)
#pragma unroll
        for (int x = 0; x < 16; ++x) o[eb][x] = 0.f;
    float s0_ = 0.f, s1_ = 0.f;
    unsigned kso[2], vso[2];
#pragma unroll
    for (int i = 0; i < 2; ++i) { const int j = 2 * wave + i;
        { const int cmp = j >> 3, row = (j & 7) * 8 + (lane >> 3), pos = lane & 7, ch = pos ^ ((row >> 1) & 7); kso[i] = (unsigned)(row * 512 + h * 128 + cmp * 64 + ch * 8); }
        { const int row = j * 4 + (lane >> 4), p16 = lane & 15, ch = (((p16 >> 2) ^ (row & 3)) << 2) | (p16 & 3); vso[i] = (unsigned)(row * 512 + h * 128 + ch * 8); } }
    const unsigned lds0 = (unsigned)(uintptr_t)lds;
#define ATT_STAGE_K(kt, buf) do { _Pragma("unroll") for (int i_ = 0; i_ < 2; ++i_) \
        glds16(Kb + (size_t)(kt) * 32768 + kso[i_], (unsigned)__builtin_amdgcn_readfirstlane(lds0 + (buf) * 16384 + (2 * wave + i_) * 1024)); } while (0)
#define ATT_STAGE_V(kt, buf) do { _Pragma("unroll") for (int i_ = 0; i_ < 2; ++i_) \
        glds16(Vb + (size_t)(kt) * 32768 + vso[i_], (unsigned)__builtin_amdgcn_readfirstlane(lds0 + 65536 + (buf) * 16384 + (2 * wave + i_) * 1024)); } while (0)
#define ATT_STAGE_STEP(kt) do { if ((kt) + 3 < ntile) ATT_STAGE_K((kt) + 3, ((kt) + 3) & 3); else ATT_STAGE_K(0, ((kt) + 3) & 3); \
        if ((kt) + 2 < ntile) ATT_STAGE_V((kt) + 2, ((kt) + 2) & 3); else ATT_STAGE_V(0, ((kt) + 2) & 3); } while (0)
    const int li = lane & 15, cb = (lane >> 4) & 1, vq = li >> 2;
    const LAS unsigned char* vrd = lds + 65536 + (4 * hh + vq) * 256 + 32 * cb + 8 * (li & 3);
    const LAS unsigned char* vb_[4]; const LAS unsigned char* kb_[4];
#pragma unroll
    for (int x = 0; x < 4; ++x) { vb_[x] = vrd + ((x ^ vq) << 6); kb_[x] = lds + comp * 8192 + r * 128 + (((2 * x + hh) ^ ((r >> 1) & 7)) << 4);
        asm volatile("" : "+v"(vb_[x]), "+v"(kb_[x])); }
#define KRDS_(slot_, i_) (*(const LAS bf16x8*)(kb_[(i_) >> 1] + (slot_) * 16384 + ((i_) & 1) * 4096))
#define VRDS_(slot_, j_, lo_, hi_) do { const LAS unsigned char* ad_ = vb_[(j_) >> 2] + (slot_) * 16384 + ((j_) & 3) * 4096; lo_ = vtr(ad_); hi_ = vtr(ad_ + 8 * 256); } while (0)
#define ATT_QK(P0, P1, buf) do { const LAS unsigned char* Kc_ = lds + (buf) * 16384 + comp * 8192; \
        _Pragma("unroll") for (int d0 = 0; d0 < 4; ++d0) { const int ch_ = 2 * d0 + hh, r1_ = 32 + r; \
            const bf16x8 kf0_ = *(const LAS bf16x8*)(Kc_ + r * 128 + ((ch_ ^ ((r >> 1) & 7)) << 4)); \
            const bf16x8 kf1_ = *(const LAS bf16x8*)(Kc_ + r1_ * 128 + ((ch_ ^ ((r1_ >> 1) & 7)) << 4)); \
            if (d0 == 0) { f32x16 z_; _Pragma("unroll") for (int x_ = 0; x_ < 16; ++x_) z_[x_] = 0.f; P0 = MFMA32(kf0_, qr[0], z_); P1 = MFMA32(kf1_, qr[0], z_); } else { P0 = MFMA32(kf0_, qr[d0], P0); P1 = MFMA32(kf1_, qr[d0], P1); } } } while (0)
#define ATT_STATS(kt, p0, p1) do { \
        if ((kt) + 4 >= ntile || (kt) == 0) { asm volatile("s_nop 15" ::: "memory");     \
            const int base_ = 64 * (kt) - (q0 + r) + 191; const bool dead_ = (kt) >= my_nt; \
            _Pragma("unroll") for (int x = 0; x < 16; ++x) { const int k0 = crow(x, hh); int i0 = base_ + k0, i1 = base_ + 32 + k0; i0 = i0 < 0 ? 0 : (i0 > 255 ? 255 : i0); i1 = i1 < 0 ? 0 : (i1 > 255 ? 255 : i1); \
                p0[x] += tb[i0]; p1[x] += tb[i1]; \
                if (dead_ || ((kt) == 0 && k0 < FPAD)) p0[x] = -1e30f; if (dead_ || ((kt) == 0 && 32 + k0 < FPAD)) p1[x] = -1e30f; } } } while (0)
#define SBAR_() __builtin_amdgcn_sched_barrier(0)
#define MFMA_ACC_(acc_, a_, b_) asm volatile("v_mfma_f32_32x32x16_bf16 %0, %1, %2, %0" : "+v"(acc_) : "v"(a_), "v"(b_))
#define MFMA_NEW_(dst_, a_, b_) asm volatile("v_mfma_f32_32x32x16_bf16 %0, %1, %2, 0" : "=&v"(dst_) : "v"(a_), "v"(b_))
#define KRD_(i_) (*(const LAS bf16x8*)(Kc_ + ((i_) & 1 ? 32 + r : r) * 128 + (((2 * ((i_) >> 1) + hh) ^ ((((i_) & 1 ? 32 + r : r) >> 1) & 7)) << 4)))
#define VRD_(j_, lo_, hi_) do { const LAS unsigned char* ad_ = Vc_ + ((j_) & 3) * 4096 + ((((j_) >> 2) ^ vq) << 6); lo_ = vtr(ad_); hi_ = vtr(ad_ + 8 * 256); } while (0)
#define VFR_(lo_, hi_) ((bf16x8){lo_[0], lo_[1], lo_[2], lo_[3], hi_[0], hi_[1], hi_[2], hi_[3]})
#define EXPV_(P0, P1, i_) do { if ((i_) < 16) { float t_ = P0[(i_) & 15]; asm volatile("v_exp_f32 %0, %0" : "+v"(t_)); P0[(i_) & 15] = t_; } else { float t_ = P1[(i_) & 15]; asm volatile("v_exp_f32 %0, %0" : "+v"(t_)); P1[(i_) & 15] = t_; } } while (0)
#define ADDV_(s_, P0, P1, i_) do { const float t_ = (i_) < 16 ? P0[(i_) & 15] : P1[(i_) & 15]; asm volatile("v_add_f32 %0, %0, %1" : "+v"(s_) : "v"(t_)); } while (0)
#define PKV_(PN, P0, P1, k_) do { const float a_ = (k_) < 8 ? P0[(2 * (k_)) & 15] : P1[(2 * (k_)) & 15], b_ = (k_) < 8 ? P0[(2 * (k_) + 1) & 15] : P1[(2 * (k_) + 1) & 15]; unsigned d_; \
        asm volatile("v_cvt_pk_bf16_f32 %0, %1, %2" : "=v"(d_) : "v"(a_), "v"(b_)); v4u w_ = __builtin_bit_cast(v4u, PN[(k_) >> 2]); w_[(k_) & 3] = d_; PN[(k_) >> 2] = __builtin_bit_cast(bf16x8, w_); } while (0)
#define VRDB_(base_, j_, lo_, hi_) do { const LAS unsigned char* ad_ = (base_) + ((j_) & 3) * 4096 + ((((j_) >> 2) ^ vq) << 6); lo_ = vtr(ad_); hi_ = vtr(ad_ + 8 * 256); } while (0)
#define ATT_MAIN(kt, PH, p0, p1, n0, n1, pa, pn) do {     \
        bf16x8 kf_[3]; \
        const int kk_ = (kt) + 3 < ntile ? (kt) + 3 : 0, vv_ = (kt) + 2 < ntile ? (kt) + 2 : 0;     \
        SBAR_(); \
          \
          \
        _Pragma("unroll") for (int g_ = 0; g_ < 24; ++g_) { \
            if (g_ < 14) VRDS_(((PH) + 3) & 3, g_ + 2, vl_[(g_ + 2) % 3], vh_[(g_ + 2) % 3]); else if (g_ < 22) kf_[(g_ - 14) % 3] = KRDS_(((PH) + 1) & 3, g_ - 14); else VRDS_((PH) & 3, g_ - 22, vl_[g_ - 22], vh_[g_ - 22]); \
            if (g_ < 16) { const bf16x8 vf_ = VFR_(vl_[g_ % 3], vh_[g_ % 3]); MFMA_ACC_(o[g_ >> 2], pa[g_ & 3], vf_); } \
            else if (g_ == 16) MFMA_NEW_(n0, kf_[0], qr[0]); else if (g_ == 17) MFMA_NEW_(n1, kf_[1], qr[0]); \
            else { if (g_ & 1) MFMA_ACC_(n1, kf_[(g_ - 16) % 3], qr[(g_ - 16) >> 1]); else MFMA_ACC_(n0, kf_[(g_ - 16) % 3], qr[(g_ - 16) >> 1]); } \
            if (g_ < 16) { EXPV_(p0, p1, 2 * g_); EXPV_(p0, p1, 2 * g_ + 1); } \
            if (g_ >= 1 && g_ <= 16) { ADDV_(s0_, p0, p1, 2 * g_ - 2); ADDV_(s1_, p0, p1, 2 * g_ - 1); } \
            if (g_ >= 16) { PKV_(pn, p0, p1, 2 * (g_ - 16)); PKV_(pn, p0, p1, 2 * (g_ - 16) + 1); } \
            if (g_ == 16 || g_ == 18) glds16s(Kb + (size_t)kk_ * 32768, 2u * kso[(g_ - 16) >> 1], (unsigned)__builtin_amdgcn_readfirstlane(lds0 + (((PH) + 3) & 3) * 16384 + (2 * wave + ((g_ - 16) >> 1)) * 1024)); \
            if (g_ == 20 || g_ == 22) glds16s(Vb + (size_t)vv_ * 32768, 2u * vso[(g_ - 20) >> 1], (unsigned)__builtin_amdgcn_readfirstlane(lds0 + 65536 + (((PH) + 2) & 3) * 16384 + (2 * wave + ((g_ - 20) >> 1)) * 1024)); \
            SBAR_(); } \
        } while (0)
    ATT_STAGE_K(0, 0); ATT_STAGE_V(0, 0); ATT_STAGE_K(1, 1); ATT_STAGE_V(1, 1); ATT_STAGE_K(2, 2);
    { _Pragma("unroll") for (int i_ = 0; i_ < 2; ++i_)
        glds16(Vb + vso[i_], (unsigned)__builtin_amdgcn_readfirstlane(lds0 + 65536 + 3 * 16384 + (2 * wave + i_) * 1024)); }
    asm volatile("s_waitcnt vmcnt(0)" ::: "memory");
    __syncthreads();
    f32x16 p0, p1, n0, n1; bf16x8 pa[4], pn[4];
#pragma unroll
    for (int x = 0; x < 4; ++x) { pa[x] = (bf16x8){0, 0, 0, 0, 0, 0, 0, 0}; pn[x] = pa[x]; }
    ATT_QK(p0, p1, 0);
    s16x4 vl_[3], vh_[3];
    VRDB_(vrd + 3 * 16384, 0, vl_[0], vh_[0]); VRDB_(vrd + 3 * 16384, 1, vl_[1], vh_[1]);
    for (int kt = 0; kt < ntile; kt += 4) {
        ATT_STATS(kt, p0, p1);
        ATT_MAIN(kt, 0, p0, p1, n0, n1, pa, pn);
        asm volatile("s_waitcnt vmcnt(4)\n\ts_barrier" ::: "memory");
        ATT_STATS(kt + 1, n0, n1);
        ATT_MAIN(kt + 1, 1, n0, n1, p0, p1, pn, pa);
        asm volatile("s_waitcnt vmcnt(4)\n\ts_barrier" ::: "memory");
        if (kt + 2 >= ntile) break;
        ATT_STATS(kt + 2, p0, p1);
        ATT_MAIN(kt + 2, 2, p0, p1, n0, n1, pa, pn);
        asm volatile("s_waitcnt vmcnt(4)\n\ts_barrier" ::: "memory");
        ATT_STATS(kt + 3, n0, n1);
        ATT_MAIN(kt + 3, 3, n0, n1, p0, p1, pn, pa);
        asm volatile("s_waitcnt vmcnt(4)\n\ts_barrier" ::: "memory");
    }
    asm volatile("s_waitcnt vmcnt(0)" ::: "memory");
    { const LAS unsigned char* Vc_ = vrd + ((ntile - 1) & 3) * 16384;
#pragma unroll
      for (int eb = 0; eb < 4; ++eb)
#pragma unroll
          for (int ks = 0; ks < 4; ++ks) { const LAS unsigned char* ad_ = Vc_ + ks * 4096 + ((eb ^ vq) << 6); const s16x4 lo_ = vtr(ad_), hi_ = vtr(ad_ + 8 * 256);
              o[eb] = MFMA32(pa[ks], ((bf16x8){lo_[0], lo_[1], lo_[2], lo_[3], hi_[0], hi_[1], hi_[2], hi_[3]}), o[eb]); } }
#undef ATT_STAGE_K
#undef ATT_STAGE_V
#undef ATT_STAGE_STEP
#undef ATT_QK
#undef ATT_STATS
#undef ATT_MAIN
#undef SBAR_
#undef MFMA_ACC_
#undef MFMA_NEW_
#undef KRD_
#undef VRD_
#undef VRDB_
#undef KRDS_
#undef VRDS_
#undef VFR_
#undef EXPV_
#undef ADDV_
#undef PKV_
    float l_run = s0_ + s1_; l_run += __shfl_xor(l_run, 32);
    { const float sc = (comp ? lam : 1.0f) / l_run;
      if (hh == 0) scr[r] = sc;
      LDS_WAIT(); asm volatile("" ::: "memory");
#pragma unroll
      for (int g4 = 0; g4 < 4; ++g4) { const f32x4 al = *(const LAS f32x4*)(scr + 8 * g4 + 4 * hh);
#pragma unroll
          for (int eb = 0; eb < 4; ++eb) { o[eb][4 * g4] *= al.x; o[eb][4 * g4 + 1] *= al.y; o[eb][4 * g4 + 2] *= al.z; o[eb][4 * g4 + 3] *= al.w; } }
    }
    __syncthreads();
    LAS float* X = (LAS float*)lds + qg * 4096;
    if (comp == 1) {
#pragma unroll
        for (int eb = 0; eb < 4; ++eb)
#pragma unroll
            for (int x = 0; x < 16; ++x) X[crow(x, hh) * 128 + 32 * eb + r] = o[eb][x];
    }
    __syncthreads();
    if (comp == 0) {
#pragma unroll
        for (int eb = 0; eb < 4; ++eb)
#pragma unroll
            for (int x = 0; x < 16; ++x) { const int xi = crow(x, hh) * 128 + 32 * eb + r; X[xi] = o[eb][x] - X[xi]; }
    }
    __syncthreads();
    { const int row = tid >> 2, qtr = tid & 3; const LAS float* xr = (const LAS float*)lds + row * 128 + 32 * qtr;
      float d[32], ss = 0.f;
#pragma unroll
      for (int j4 = 0; j4 < 8; ++j4) { const f32x4 v = *(const LAS f32x4*)(xr + 4 * j4); d[4 * j4] = v.x; d[4 * j4 + 1] = v.y; d[4 * j4 + 2] = v.z; d[4 * j4 + 3] = v.w; ss += (v.x * v.x + v.y * v.y) + (v.z * v.z + v.w * v.w); }
      ss = quad_sum(ss);
      const float rstd = (1.0f - LAM_INIT) / sqrtf(ss * (1.0f / 128.0f) + NORM_EPS);
      const float* sg = a.in[I_SUBLN] + 32 * qtr;
      bf16* dst = MIX + (size_t)(128 * qt + row) * 1024 + h * 128 + 32 * qtr;
#pragma unroll
      for (int j8 = 0; j8 < 4; ++j8) { v4u w;
          w.x = pk2(d[8 * j8] * rstd * sg[8 * j8], d[8 * j8 + 1] * rstd * sg[8 * j8 + 1]); w.y = pk2(d[8 * j8 + 2] * rstd * sg[8 * j8 + 2], d[8 * j8 + 3] * rstd * sg[8 * j8 + 3]);
          w.z = pk2(d[8 * j8 + 4] * rstd * sg[8 * j8 + 4], d[8 * j8 + 5] * rstd * sg[8 * j8 + 5]); w.w = pk2(d[8 * j8 + 6] * rstd * sg[8 * j8 + 6], d[8 * j8 + 7] * rstd * sg[8 * j8 + 7]);
          *(v4u*)(dst + 8 * j8) = w; }
    }
    __syncthreads();
}
__device__ __forceinline__ void ph_attn(const Args& a, LAS unsigned char* lds, gu32* ctl, volatile LAS unsigned* misc, float lam, int tid, int wave, int lane) {
    LAS float* dtb = (LAS float*)(lds + ATT_TB_OFF + 2048);
    for (int hh = 0; hh < 4; ++hh) build_bias_table(dtb + 256 * hh, a.in[I_RELB], hh, tid);
    __syncthreads();
    const unsigned myh = xb_xcc_id() & 3u;
    for (;;) {
        if (tid == 0) { const unsigned t = __hip_atomic_fetch_add(ctl + CW_QATT, 1u, __ATOMIC_RELAXED, __HIP_MEMORY_SCOPE_AGENT); unsigned uu = 0u;
            if (t < 772u && !(t < 768u && t % 3u == 2u)) {
                for (unsigned k = 0; k < 4u; ++k) { const unsigned hq = (myh + k) & 3u; const unsigned j = __hip_atomic_fetch_add(ctl + CW_QH + 64 * hq, 1u, __ATOMIC_RELAXED, __HIP_MEMORY_SCOPE_AGENT);
                    if (j < 129u) { uu = 4u * j + hq; break; } } }
            misc[4] = t; misc[5] = uu; }
        __syncthreads();
        const unsigned it = (unsigned)__builtin_amdgcn_readfirstlane((int)misc[4]);
        const unsigned au = (unsigned)__builtin_amdgcn_readfirstlane((int)misc[5]);
        __syncthreads();
        if (it >= 772u + 265u + 256u) break;
        const int kind = it >= 772u + 265u ? 3 : it >= 772u ? 2 : (it < 768u && it % 3u == 2u) ? 1 : 0;
        if (tid == 0 && kind >= 2) { gu32* w = ctl + (kind == 3 ? CW_DECDONE : CW_R2DONE); const unsigned want = kind == 3 ? 256u : 32u; unsigned sp = 0;
            while (__hip_atomic_load(w, __ATOMIC_RELAXED, __HIP_MEMORY_SCOPE_AGENT) < want && ++sp < (1u << 22)) __builtin_amdgcn_s_sleep(8);
            __builtin_amdgcn_fence(__ATOMIC_ACQUIRE, "agent"); asm volatile("s_waitcnt vmcnt(0)" ::: "memory"); }
        __syncthreads();
        if (kind == 0) attn_unit(a, lds, (int)(au & 3u), 128 - (int)(au >> 2), lam, tid, wave, lane);
        else if (kind == 1) { const unsigned du = it / 3u; dec_attn_unit(a, lds, dtb + 256 * ((du >> 1) & 3), (int)du, wave, lane); }
        else if (kind == 2) { const unsigned bi = it - 772u; const int tl = bi < 256u ? 1 + (int)bi : (bi == 256u ? 0 : cfg::NCH + (int)(bi - 257u)); r3_unit(a, tl, wave, lane); }
        else decfin_row(a, (int)(it - 772u - 265u) * 8 + wave, lane, lam);
        asm volatile("s_waitcnt vmcnt(0)" ::: "memory");
        __syncthreads();
        if (tid == 0 && kind == 1) { __builtin_amdgcn_fence(__ATOMIC_RELEASE, "agent"); asm volatile("s_waitcnt vmcnt(0)" ::: "memory"); (void)__hip_atomic_fetch_add(ctl + CW_DECDONE, 1u, __ATOMIC_RELAXED, __HIP_MEMORY_SCOPE_AGENT); }
    }
}

__device__ __forceinline__ void ph_norm2(const Args& a, int gw, int NGW, int lane) {
    const float* X1 = (const float*)(a.ws + WS_X1); bf16* XN = (bf16*)(a.ws + WS_XN);
    for (int m = gw; m < cfg::M; m += NGW) rms_row_bf16(X1 + (size_t)m * 1024, a.in[I_LN2], XN + (size_t)m * 1024, lane);
}
__device__ __forceinline__ void ph_conv(const Args& a, int gw, int NGW, int lane) {
    using namespace cfg;
    const bf16* Z = (const bf16*)(a.ws + WS_Z); bf16* ACT = (bf16*)(a.ws + WS_ACT);
    const float* cw = a.in[I_CONVW]; const float* cbias = a.in[I_CONVB]; const float* sconv = a.in[I_SCV];
    constexpr int NSEGP = MP / 8, NSEG = NSEGP + MD / 8, NLI = NSEG * 352;
    for (int li = gw * 64 + lane; li < NLI; li += NGW * 64) {
        const int seg = li / 352, cg = li - seg * 352, r0 = seg < NSEGP ? 8 * seg : MPP + 8 * (seg - NSEGP);
        const int c8 = cg * 8;
        const bool dec = r0 >= MPP; const int t0 = dec ? ((r0 - MPP) & 15) : 0, b = dec ? ((r0 - MPP) >> 4) : 0;
        v4u zr[10][2];
        f32x4 hs[2][2][2];
        const bool use_state = dec && t0 == 0, zero_halo = !dec && r0 == 0;
#pragma unroll
        for (int j = 0; j < 10; ++j) { const int row = r0 - 2 + j;
            if (j >= 2 || !(use_state || zero_halo)) { zr[j][0] = *(const v4u*)(Z + (size_t)row * NUP + c8); zr[j][1] = *(const v4u*)(Z + (size_t)row * NUP + DFF + c8); }
            else { zr[j][0] = (v4u){0u, 0u, 0u, 0u}; zr[j][1] = zr[j][0]; } }
        if (use_state) {
#pragma unroll
            for (int j = 0; j < 2; ++j)
#pragma unroll
                for (int hf = 0; hf < 2; ++hf) { const float* sr = sconv + ((size_t)b * 2 + j) * NUP + hf * DFF + c8; hs[j][hf][0] = *(const f32x4*)sr; hs[j][hf][1] = *(const f32x4*)(sr + 4); }
        }
        float wv[3][2][8], bv[2][8];
#pragma unroll
        for (int hf = 0; hf < 2; ++hf) { const f32x4 b0 = *(const f32x4*)(cbias + hf * DFF + c8), b1 = *(const f32x4*)(cbias + hf * DFF + c8 + 4);
            bv[hf][0] = b0.x; bv[hf][1] = b0.y; bv[hf][2] = b0.z; bv[hf][3] = b0.w; bv[hf][4] = b1.x; bv[hf][5] = b1.y; bv[hf][6] = b1.z; bv[hf][7] = b1.w;
#pragma unroll
            for (int j = 0; j < 3; ++j) { const f32x4 w0 = *(const f32x4*)(cw + (size_t)j * NUP + hf * DFF + c8), w1 = *(const f32x4*)(cw + (size_t)j * NUP + hf * DFF + c8 + 4);
                wv[j][hf][0] = w0.x; wv[j][hf][1] = w0.y; wv[j][hf][2] = w0.z; wv[j][hf][3] = w0.w; wv[j][hf][4] = w1.x; wv[j][hf][5] = w1.y; wv[j][hf][6] = w1.z; wv[j][hf][7] = w1.w; } }
        float z2[2][8], z1[2][8], z0[2][8];
#pragma unroll
        for (int hf = 0; hf < 2; ++hf) {
            if (use_state) {
#pragma unroll
                for (int e = 0; e < 4; ++e) { z2[hf][e] = hs[0][hf][0][e]; z2[hf][4 + e] = hs[0][hf][1][e]; z1[hf][e] = hs[1][hf][0][e]; z1[hf][4 + e] = hs[1][hf][1][e]; } }
            else { unpack8(zr[0][hf], z2[hf]); unpack8(zr[1][hf], z1[hf]); }
        }
#pragma unroll
        for (int t = 0; t < 8; ++t) {
            unpack8(zr[2 + t][0], z0[0]); unpack8(zr[2 + t][1], z0[1]);
            float act[8];
#pragma unroll
            for (int e = 0; e < 8; ++e) {
                const float gt = bv[0][e] + z2[0][e] * wv[0][0][e] + z1[0][e] * wv[1][0][e] + z0[0][e] * wv[2][0][e];
                const float up = bv[1][e] + z2[1][e] * wv[0][1][e] + z1[1][e] * wv[1][1][e] + z0[1][e] * wv[2][1][e];
                act[e] = gt * sigm(gt) * up;
            }
            v4u w; w.x = pk2(act[0], act[1]); w.y = pk2(act[2], act[3]); w.z = pk2(act[4], act[5]); w.w = pk2(act[6], act[7]);
            *(v4u*)(ACT + (size_t)(r0 + t) * DFF + c8) = w;
            if (t >= 6) {
                float* cd = nullptr;
                if (r0 + 7 == MP - 1) cd = a.out + O_CP + (size_t)(t - 6) * NUP; else if (dec && t0 == 8) cd = a.out + O_CS + ((size_t)b * 2 + (t - 6)) * NUP;
                if (cd) {
#pragma unroll
                    for (int hf = 0; hf < 2; ++hf) { *(f32x4*)(cd + hf * DFF + c8) = (f32x4){z0[hf][0], z0[hf][1], z0[hf][2], z0[hf][3]}; *(f32x4*)(cd + hf * DFF + c8 + 4) = (f32x4){z0[hf][4], z0[hf][5], z0[hf][6], z0[hf][7]}; }
                }
            }
#pragma unroll
            for (int hf = 0; hf < 2; ++hf)
#pragma unroll
                for (int e = 0; e < 8; ++e) { z2[hf][e] = z1[hf][e]; z1[hf][e] = z0[hf][e]; }
        }
    }
}

__device__ __forceinline__ void ph_convfix(const Args& a, int gw, int NGW, int lane) {
    using namespace cfg;
    const bf16* Z = (const bf16*)(a.ws + WS_Z); bf16* ACT = (bf16*)(a.ws + WS_ACT);
    const float* cw = a.in[I_CONVW]; const float* cbias = a.in[I_CONVB]; const float* sconv = a.in[I_SCV];
    constexpr int NB = 256 + DB, NLI = NB * 352;
    for (int li = gw * 64 + lane; li < NLI; li += NGW * 64) {
        const int bi = li / 352, cg = li - bi * 352, c8 = 8 * cg, zc = 256 * (c8 >> 7) + (c8 & 127);
        const bool dec = bi >= 256; const int b = bi - 256, r0 = dec ? MPP + 16 * b : 64 * (bi + 1);
        float zz[4][2][8];
#pragma unroll
        for (int j = 0; j < 4; ++j)
#pragma unroll
            for (int hf = 0; hf < 2; ++hf) {
                if (j < 2 && dec) { const float* sr = sconv + ((size_t)b * 2 + j) * NUP + hf * DFF + c8; const f32x4 s0 = *(const f32x4*)sr, s1 = *(const f32x4*)(sr + 4);
                    zz[j][hf][0] = s0.x; zz[j][hf][1] = s0.y; zz[j][hf][2] = s0.z; zz[j][hf][3] = s0.w; zz[j][hf][4] = s1.x; zz[j][hf][5] = s1.y; zz[j][hf][6] = s1.z; zz[j][hf][7] = s1.w; }
                else unpack8(*(const v4u*)(Z + (size_t)(r0 - 2 + j) * NUP + zc + 128 * hf), zz[j][hf]); }
        float wv[3][2][8], bv[2][8];
#pragma unroll
        for (int hf = 0; hf < 2; ++hf) { const f32x4 b0 = *(const f32x4*)(cbias + hf * DFF + c8), b1 = *(const f32x4*)(cbias + hf * DFF + c8 + 4);
            bv[hf][0] = b0.x; bv[hf][1] = b0.y; bv[hf][2] = b0.z; bv[hf][3] = b0.w; bv[hf][4] = b1.x; bv[hf][5] = b1.y; bv[hf][6] = b1.z; bv[hf][7] = b1.w;
#pragma unroll
            for (int j = 0; j < 3; ++j) { const f32x4 w0 = *(const f32x4*)(cw + (size_t)j * NUP + hf * DFF + c8), w1 = *(const f32x4*)(cw + (size_t)j * NUP + hf * DFF + c8 + 4);
                wv[j][hf][0] = w0.x; wv[j][hf][1] = w0.y; wv[j][hf][2] = w0.z; wv[j][hf][3] = w0.w; wv[j][hf][4] = w1.x; wv[j][hf][5] = w1.y; wv[j][hf][6] = w1.z; wv[j][hf][7] = w1.w; } }
#pragma unroll
        for (int t = 0; t < 2; ++t) { float act[8];
#pragma unroll
            for (int e = 0; e < 8; ++e) {
                const float gt = bv[0][e] + zz[t][0][e] * wv[0][0][e] + zz[t + 1][0][e] * wv[1][0][e] + zz[t + 2][0][e] * wv[2][0][e];
                const float up = bv[1][e] + zz[t][1][e] * wv[0][1][e] + zz[t + 1][1][e] * wv[1][1][e] + zz[t + 2][1][e] * wv[2][1][e];
                act[e] = gt * sigm(gt) * up; }
            v4u w; w.x = pk2(act[0], act[1]); w.y = pk2(act[2], act[3]); w.z = pk2(act[4], act[5]); w.w = pk2(act[6], act[7]);
            *(v4u*)(ACT + (size_t)(r0 + t) * DFF + c8) = w; }
    }
}

template <class Fin>
__device__ __forceinline__ void gemm_small(LAS unsigned char* lds, const bf16* A, const bf16* Bt, int K, int piece, int tid, int wave, int lane, const Fin& fin) {
    asm volatile("" : "+v"(lane), "+v"(tid));
    const int rb = piece >> 4, cb = piece & 15;
    const int row0 = rb == 0 ? 16384 : cfg::MPP + 64 * (rb - 1), col0 = 64 * cb;
    const int fr = lane & 15, fq = lane >> 4;
    const int kw = K >> 3, k0 = wave * kw;
    f32x4 acc[4][4];
#pragma unroll
    for (int m = 0; m < 4; ++m)
#pragma unroll
        for (int n = 0; n < 4; ++n) acc[m][n] = (f32x4){0.f, 0.f, 0.f, 0.f};
    const bf16* ap = A + (size_t)(row0 + fr) * K + k0 + 8 * fq;
    const bf16* bp = Bt + (size_t)(col0 + fr) * K + k0 + 8 * fq;
#pragma unroll 1
    for (int ks = 0; ks < kw; ks += 128) {
        bf16x8 af[4][4], bf[4][4];
#pragma unroll
        for (int j = 0; j < 4; ++j) { const int kk = ks + 32 * j < kw ? ks + 32 * j : 0;
#pragma unroll
            for (int m = 0; m < 4; ++m) { af[j][m] = *(const bf16x8*)(ap + (size_t)(16 * m) * K + kk); bf[j][m] = *(const bf16x8*)(bp + (size_t)(16 * m) * K + kk); } }
#pragma unroll
        for (int j = 0; j < 4; ++j) if (ks + 32 * j < kw) {
#pragma unroll
            for (int m = 0; m < 4; ++m)
#pragma unroll
                for (int n = 0; n < 4; ++n) acc[m][n] = MFMA16(bf[j][n], af[j][m], acc[m][n]); }
    }
    LAS unsigned char* part = lds + wave * 16384;
#pragma unroll
    for (int m = 0; m < 4; ++m)
#pragma unroll
        for (int n = 0; n < 4; ++n) *(LAS f32x4*)(part + (16 * m + fr) * 256 + (((4 * n + fq) ^ fr) << 4)) = acc[m][n];
    __syncthreads();
    { const int row = tid >> 3, c8 = tid & 7; float v[8];
#pragma unroll
      for (int e = 0; e < 8; ++e) v[e] = 0.f;
#pragma unroll
      for (int w = 0; w < 8; ++w) { const f32x4 x0 = *(const LAS f32x4*)(lds + w * 16384 + row * 256 + (((2 * c8) ^ (row & 15)) << 4)), x1 = *(const LAS f32x4*)(lds + w * 16384 + row * 256 + (((2 * c8 + 1) ^ (row & 15)) << 4));
          v[0] += x0.x; v[1] += x0.y; v[2] += x0.z; v[3] += x0.w; v[4] += x1.x; v[5] += x1.y; v[6] += x1.z; v[7] += x1.w; }
      fin(row0 + row, col0 + 8 * c8, v); }
    __syncthreads();
}
struct FinX1 {
    const float* xp; const float* xs; const float* meta; float* X1; bf16* XB; unsigned long long* SSQ; const float* gain;
    __device__ __forceinline__ void operator()(int r, int c, const float (&v)[8]) const {
        const f32x4 g0 = *(const f32x4*)(gain + c), g1 = *(const f32x4*)(gain + c + 4);
        const float* src = pg8::x_src_row(r, xp, xs, meta) + c; float* dst = X1 + (size_t)r * cfg::DM + c;
        const f32x4 s0 = *(const f32x4*)src, s1 = *(const f32x4*)(src + 4);
        const f32x4 y0 = (f32x4){s0.x + v[0], s0.y + v[1], s0.z + v[2], s0.w + v[3]}, y1 = (f32x4){s1.x + v[4], s1.y + v[5], s1.z + v[6], s1.w + v[7]};
        *(f32x4*)dst = y0; *(f32x4*)(dst + 4) = y1;
        v4u w; w.x = pk2(y0.x * g0.x, y0.y * g0.y); w.y = pk2(y0.z * g0.z, y0.w * g0.w); w.z = pk2(y1.x * g1.x, y1.y * g1.y); w.w = pk2(y1.z * g1.z, y1.w * g1.w); *(v4u*)(XB + (size_t)r * cfg::DM + c) = w;
        float ss = ((y0.x * y0.x + y0.y * y0.y) + (y0.z * y0.z + y0.w * y0.w)) + ((y1.x * y1.x + y1.y * y1.y) + (y1.z * y1.z + y1.w * y1.w));
        ss += __shfl_xor(ss, 1); ss += __shfl_xor(ss, 2); ss += __shfl_xor(ss, 4);
        if ((threadIdx.x & 7) == 0) (void)__hip_atomic_fetch_add(SSQ + r, (unsigned long long)(ss * 16777216.0f), __ATOMIC_RELAXED, __HIP_MEMORY_SCOPE_AGENT);
    }
};
struct FinY {
    const float* X1; float* out;
    __device__ __forceinline__ void operator()(int r, int c, const float (&v)[8]) const {
        using namespace cfg;
        float* dst = (r < MP ? out + O_YP + (size_t)(r - FPAD - NMETA) * DM : out + O_YS + (size_t)(r - MPP) * DM) + c; const float* src = X1 + (size_t)r * DM + c;
        const f32x4 s0 = *(const f32x4*)src, s1 = *(const f32x4*)(src + 4);
        *(f32x4*)dst = (f32x4){s0.x + v[0], s0.y + v[1], s0.z + v[2], s0.w + v[3]}; *(f32x4*)(dst + 4) = (f32x4){s1.x + v[4], s1.y + v[5], s1.z + v[6], s1.w + v[7]};
    }
};

template <int PMASK> __global__ void __launch_bounds__(NWAVES * 64, 2) mk_fwd(Args args) {
    extern __shared__ __attribute__((aligned(16))) unsigned char lds_raw[];
    using namespace cfg;
    LAS unsigned char* lds = (LAS unsigned char*)lds_raw;
    volatile LAS unsigned* MISC = (volatile LAS unsigned*)(lds + MISC_OFF);
    const int tid = threadIdx.x, lane = tid & 63, wave = __builtin_amdgcn_readfirstlane(tid >> 6);
    const int G = gridDim.x, bx = blockIdx.x, vcu = (G % 8 == 0) ? (bx % 8) * (G / 8) + bx / 8 : bx;
    const int gw = vcu * NWAVES + wave, NGW = G * NWAVES;
    gu32* ctl = (gu32*)(args.ws + WS_CTL);
    for (int u = tid; u < (LDS_BYTES - LDSCTL_OFF) / 4; u += NWAVES * 64) ((LAS unsigned*)(lds + LDSCTL_OFF))[u] = 0u;
    __syncthreads();
    XcdBarrier bar; bar.bar = (unsigned*)(ctl + CW_BAR) + args.li * XCD_BAR_WORDS; bar.x = 0; bar.st = nullptr;
    if (N_LAUNCHES != N_PHASES) bar = xcd_barrier_post((unsigned*)(ctl + CW_BAR) + args.li * XCD_BAR_WORDS, MISC + 8);
#define GRID_BAR() do { if (N_LAUNCHES != N_PHASES) xcd_barrier(bar); } while (0)
    const int lo = args.ph_lo, hi = args.ph_hi;
#define IN(k) (((PMASK >> (k)) & 1) && lo <= (k) && (k) < hi)
#define BOTH(k) (IN(k) && IN((k) + 1))
#ifndef REP_PHASE
#define REP_PHASE -1
#endif
#define NREP(k) ((k) == REP_PHASE ? 2 : 1)
#define LAMBDA() (expf(wave_sum(args.in[I_LQ1][lane] * args.in[I_LK1][lane])) - expf(wave_sum(args.in[I_LQ2][lane] * args.in[I_LK2][lane])) + LAM_INIT)

    if (IN(0)) for (int rep = 0; rep < NREP(0); ++rep) { ph_prologue(args, lds, gw, NGW, wave, lane); if (BOTH(0)) GRID_BAR(); }
    if (IN(1)) for (int rep = 0; rep < NREP(1); ++rep) {
        pg8::Gemm g{(const pg8::bf16_t*)(args.ws + WS_XN), (const pg8::bf16_t*)(args.ws + WS_WIN), M, NPROJ, DM}; pg8::StaticOrder S; S.init(M, NPROJ, G, bx);
        pg8::EpiBf E{(pg8::bf16_t*)(args.ws + WS_PROJ), NPROJ};
        pg8::gemm_phase<pg8::EpiBf, pg8::StaticOrder, true, true>(lds + RING_OFF, g, S, E);
        if (BOTH(1)) GRID_BAR();
    }
    if (IN(2)) for (int rep = 0; rep < NREP(2); ++rep) { ph_rowpass(args, gw, NGW, lane); if (BOTH(2)) GRID_BAR(); }
    if (IN(3)) for (int rep = 0; rep < NREP(3); ++rep) {
        pg8::Gemm g{(const pg8::bf16_t*)(args.ws + WS_LIN), (const pg8::bf16_t*)(args.ws + WS_WLT), M, 1536, 256}; pg8::StaticOrder S; S.init(M, 1536, G, bx);
        pg8::EpiBf E{(pg8::bf16_t*)(args.ws + WS_LW), 1536};
        pg8::gemm_phase<pg8::EpiBf, pg8::StaticOrder, true, true>(lds + RING_OFF, g, S, E);
        if (BOTH(3)) GRID_BAR();
    }
    if (IN(4)) for (int rep = 0; rep < NREP(4); ++rep) { ph_r1(args, lds, bx, G, tid, wave, lane); if (rep == 0 && bx >= 66 && G > 66) { __syncthreads(); late_weights(args, lds, (bx - 66) * NWAVES + wave, (G - 66) * NWAVES, wave, lane); } if (BOTH(4)) GRID_BAR(); }
    if (IN(5)) for (int rep = 0; rep < NREP(5); ++rep) { const float lam = LAMBDA(); if (bx < 32) ph_r2(args, lds, bx, wave, lane, ctl + 256 * rep + CW_R2DONE); __syncthreads(); ph_attn(args, lds, ctl + 256 * rep, MISC, lam, tid, wave, lane); if (IN(5) && IN(8)) GRID_BAR(); }
    if (IN(8)) for (int rep = 0; rep < NREP(8); ++rep) {
        pg8::Gemm g{(const pg8::bf16_t*)(args.ws + WS_MIX), (const pg8::bf16_t*)(args.ws + WS_WOUT), 16384, DM, DM}; pg8::StaticOrder S; S.init(16384, DM, G, bx);
        unsigned long long* SSQ = (unsigned long long*)(args.ws + WS_CTL + WS_SSQ_OFF);
        pg8::EpiX1 E{args.in[I_XP], args.in[I_XS], args.in[I_META], (float*)(args.ws + WS_X1), (pg8::bf16_t*)(args.ws + WS_XN), SSQ, args.in[I_LN2]};
        pg8::gemm_phase<pg8::EpiX1, pg8::StaticOrder, true, true>(lds + RING_OFF, g, S, E);
        { const FinX1 F{args.in[I_XP], args.in[I_XS], args.in[I_META], (float*)(args.ws + WS_X1), (bf16*)(args.ws + WS_XN), SSQ, args.in[I_LN2]};
          for (int pc = bx; pc < 144; pc += G) gemm_small(lds, (const bf16*)(args.ws + WS_MIX), (const bf16*)(args.ws + WS_WOUT), DM, pc, tid, wave, lane, F);
          if (bx >= 144 || G <= 144) { float* zp = (float*)(args.ws + WS_X1) + (size_t)MP * DM; const int nz = (MPP - MP) * DM / 4, zb = G > 144 ? bx - 144 : bx, zn = G > 144 ? G - 144 : G;
              for (int i = zb * (NWAVES * 64) + tid; i < nz; i += zn * (NWAVES * 64)) ((f32x4*)zp)[i] = (f32x4){0.f, 0.f, 0.f, 0.f};
              f32x4* zq = (f32x4*)((bf16*)(args.ws + WS_XN) + (size_t)MP * DM); for (int i = zb * (NWAVES * 64) + tid; i < nz / 2; i += zn * (NWAVES * 64)) zq[i] = (f32x4){0.f, 0.f, 0.f, 0.f}; } }
        if (BOTH(8)) GRID_BAR();
    }
    if (IN(10)) for (int rep = 0; rep < NREP(10); ++rep) {
        pg8::Gemm g{(const pg8::bf16_t*)(args.ws + WS_XN), (const pg8::bf16_t*)(args.ws + WS_WUP), M, NUP, DM}; pg8::StaticOrder S; S.init(M, NUP, G, bx);
        pg8::EpiConv E{(pg8::bf16_t*)(args.ws + WS_Z), (pg8::bf16_t*)(args.ws + WS_ACT), (const unsigned long long*)(args.ws + WS_CTL + WS_SSQ_OFF), args.in[I_CONVW], args.in[I_CONVB], args.out};
        pg8::gemm_phase<pg8::EpiConv, pg8::StaticOrder, true, true>(lds + RING_OFF, g, S, E);
        if (BOTH(10)) GRID_BAR();
    }
    if (IN(11)) for (int rep = 0; rep < NREP(11); ++rep) { ph_convfix(args, gw, NGW, lane); if (BOTH(11)) GRID_BAR(); }
    if (IN(12)) for (int rep = 0; rep < NREP(12); ++rep) {
        pg8::Gemm g{(const pg8::bf16_t*)(args.ws + WS_ACT), (const pg8::bf16_t*)(args.ws + WS_WDN), 16384, DM, DFF}; pg8::StaticOrder S; S.init(16384, DM, G, bx);
        pg8::EpiY E{(const float*)(args.ws + WS_X1), args.out};
        pg8::gemm_phase<pg8::EpiY, pg8::StaticOrder, true, true>(lds + RING_OFF, g, S, E);
        { const FinY F{(const float*)(args.ws + WS_X1), args.out};
          for (int pc = bx; pc < 144; pc += G) gemm_small(lds, (const bf16*)(args.ws + WS_ACT), (const bf16*)(args.ws + WS_WDN), DFF, pc, tid, wave, lane, F); }
        if (rep + 1 < NREP(12)) GRID_BAR();
    }
#undef IN
#undef BOTH
#undef GRID_BAR
}


#ifndef PH_MASK
#define PH_MASK 0x1fff
#endif
template <int K> struct PhaseKernels {
    static hipError_t set_attr() { hipError_t e = hipFuncSetAttribute((const void*)mk_fwd<(1 << K)>, hipFuncAttributeMaxDynamicSharedMemorySize, LDS_BYTES); if (e != hipSuccess) return e; return PhaseKernels<K - 1>::set_attr(); }
    static void launch(int li, int grid, hipStream_t stream, const Args& a) { if (li == K) hipLaunchKernelGGL(mk_fwd<(1 << K)>, dim3(grid), dim3(NWAVES * 64), LDS_BYTES, stream, a); else PhaseKernels<K - 1>::launch(li, grid, stream, a); }
};
template <> struct PhaseKernels<-1> { static hipError_t set_attr() { return hipSuccess; } static void launch(int, int, hipStream_t, const Args&) {} };
static hipError_t set_lds_attr() {
    if constexpr (N_LAUNCHES == 1) return hipFuncSetAttribute((const void*)mk_fwd<PH_MASK>, hipFuncAttributeMaxDynamicSharedMemorySize, LDS_BYTES);
    else return PhaseKernels<N_PHASES - 1>::set_attr();
}
static void launch_one(int li, int grid, hipStream_t stream, const Args& a) {
    if constexpr (N_LAUNCHES == 1) hipLaunchKernelGGL(mk_fwd<PH_MASK>, dim3(grid), dim3(NWAVES * 64), LDS_BYTES, stream, a);
    else PhaseKernels<N_PHASES - 1>::launch(li, grid, stream, a);
}
extern "C" void kernel_launch(void* const* d_in, const int* in_sizes, int n_in, void* d_out, int out_size, void* d_ws, size_t ws_size, hipStream_t stream) {
    static int grid = 0;
    if (grid == 0) {
        if (n_in != 35 || out_size != (int)cfg::O_END || ws_size < WS_END) { fprintf(stderr, "kernel_launch: unexpected shapes: n_in %d out %d ws %zu (need %zu); nothing launched\n", n_in, out_size, ws_size, (size_t)WS_END); grid = -1; return; }
        int dev = 0, cus = 0;
        if (hipGetDevice(&dev) != hipSuccess || hipDeviceGetAttribute(&cus, hipDeviceAttributeMultiprocessorCount, dev) != hipSuccess) { fprintf(stderr, "kernel_launch: device query failed\n"); grid = -1; return; }
        if (set_lds_attr() != hipSuccess) { fprintf(stderr, "kernel_launch: hipFuncSetAttribute failed\n"); grid = -1; return; }
        (void)hipGetLastError();
        grid = cus;
        if (grid < 32) { fprintf(stderr, "kernel_launch: needs >= 32 CUs\n"); grid = -1; return; }
    }
    if (grid < 0) return;
    if (hipMemsetAsync((char*)d_ws + WS_CTL, 0, CTL_ZERO_BYTES, stream) != hipSuccess) { fprintf(stderr, "kernel_launch: memset failed\n"); return; }
    Args a{};
    for (int i = 0; i < 35; ++i) a.in[i] = (const float*)d_in[i];
    a.out = (float*)d_out; a.ws = (unsigned char*)d_ws;
    static_assert(N_LAUNCHES == 1 || N_LAUNCHES == N_PHASES, "MK_N_LAUNCHES: 1 or 13");
    for (int li = 0; li < N_LAUNCHES; ++li) {
        a.ph_lo = (N_LAUNCHES == 1) ? 0 : li; a.ph_hi = (N_LAUNCHES == 1) ? N_PHASES : li + 1; a.li = (N_LAUNCHES == 1) ? 0 : 0;
        launch_one(li, grid, stream, a);
        const hipError_t le = hipPeekAtLastError();
        if (le != hipSuccess) { fprintf(stderr, "kernel_launch: launch %d failed: %s\n", li, hipGetErrorName(le)); break; }
    }
}
```
